# Optimizing an MI355X kernel written in HIP

```python
import jax, jax.numpy as jnp
from jax import lax
import numpy as np

D_MODEL = 1024
BATCH = 16
SEQ = 2048
DEPTH = 2

GRID_W = 64
CTX_LEN = 256

N_EVEN = (DEPTH + 1) // 2
N_ODD = DEPTH // 2

N_HEADS = 8
Q_LORA = 384
KV_LORA = 256
NOPE_DIM = 64
ROPE_DIM = 32
QK_DIM = NOPE_DIM + ROPE_DIM
V_DIM = 64
ROPE_THETA = 10000.0
Q_BLOCK = 128

CONV_CH = 512
CONV_W = 31

A_IN = Q_LORA + KV_LORA + ROPE_DIM + 2 * CONV_CH
MIX_WIDTH = N_HEADS * V_DIM + CONV_CH

SG_DIM = 2 * D_MODEL
CHUNK = 128
SG_GROUPS = 8
SG_CH = SG_DIM // SG_GROUPS

N_GROUPS = 4
EXPERTS_PER_GROUP = 8
N_EXPERTS = N_GROUPS * EXPERTS_PER_GROUP
TOP_K = 2
D_EXPERT = 256

kernel_name = "hybrid_mla_conformer_gmlp_hmoe_dit"


def rms_norm(x, g, eps=1e-6):
    xf = x.astype(jnp.float32)
    y = xf * lax.rsqrt(jnp.mean(xf * xf, axis=-1, keepdims=True) + eps)
    return (y * g.astype(jnp.float32)).astype(x.dtype)


def layer_norm(x, g, b, eps=1e-5):
    xf = x.astype(jnp.float32)
    mu = jnp.mean(xf, axis=-1, keepdims=True)
    var = jnp.mean(jnp.square(xf - mu), axis=-1, keepdims=True)
    y = (xf - mu) * lax.rsqrt(var + eps)
    return (y * g.astype(jnp.float32) + b.astype(jnp.float32)).astype(x.dtype)


def modulate(h, shift, scale):
    return h * (1 + scale) + shift


def axial_rope(n_tokens, dtype):
    rows = n_tokens // GRID_W
    t = jnp.arange(rows * GRID_W)
    row = (t // GRID_W).astype(jnp.float32)
    col = (t % GRID_W).astype(jnp.float32)
    n_freq = ROPE_DIM // 4
    inv_freq = ROPE_THETA ** (-jnp.arange(n_freq, dtype=jnp.float32) / n_freq)
    ang = jnp.concatenate([row[:, None] * inv_freq, col[:, None] * inv_freq], axis=-1)
    return jnp.cos(ang).astype(dtype), jnp.sin(ang).astype(dtype)


def rope_tail(x, cos, sin):
    half = ROPE_DIM // 2
    xn = x[..., :NOPE_DIM]
    x1 = x[..., NOPE_DIM:NOPE_DIM + half]
    x2 = x[..., NOPE_DIM + half:]
    cs = cos[None, :, None, :]
    sn = sin[None, :, None, :]
    return jnp.concatenate([xn, x1 * cs - x2 * sn, x1 * sn + x2 * cs], axis=-1)


def mla_queries(q_lat, q_norm_g, w_uq, q_g, rope):
    q = rms_norm(q_lat, q_norm_g) @ w_uq
    q = q.reshape(q.shape[:-1] + (N_HEADS, QK_DIM))
    q = rms_norm(q, q_g)
    if rope is not None:
        q = rope_tail(q, *rope)
    return q


def mla_keys_values(kv_lat, k_rope, kv_norm_g, w_ukv, k_g, rope):
    kv = rms_norm(kv_lat, kv_norm_g) @ w_ukv
    kv = kv.reshape(kv.shape[:-1] + (N_HEADS, NOPE_DIM + V_DIM))
    k_nope, v = kv[..., :NOPE_DIM], kv[..., NOPE_DIM:]
    kr = jnp.broadcast_to(k_rope[..., None, :], k_nope.shape[:-1] + (ROPE_DIM,))
    k = rms_norm(jnp.concatenate([k_nope, kr], axis=-1), k_g)
    if rope is not None:
        k = rope_tail(k, *rope)
    return k, v


def attend(q, k, v):
    s = jnp.einsum('bqhd,bkhd->bhqk', q, k).astype(jnp.float32) * (QK_DIM ** -0.5)
    p = jax.nn.softmax(s, axis=-1).astype(v.dtype)
    return jnp.einsum('bhqk,bkhd->bqhd', p, v)


def latent_attention(q, k_all, v_all):
    B, S = q.shape[0], q.shape[1]
    nb = S // Q_BLOCK
    qb = q.reshape(B, nb, Q_BLOCK, N_HEADS, QK_DIM).transpose(1, 0, 2, 3, 4)
    o = lax.map(lambda qblk: attend(qblk, k_all, v_all), qb)
    return o.transpose(1, 0, 2, 3, 4).reshape(B, S, N_HEADS * V_DIM)


def conformer_conv(g, w_dw, b_dw, ln_g, ln_b):
    a, b = jnp.split(g, 2, axis=-1)
    z = a * jax.nn.sigmoid(b)
    z = lax.conv_general_dilated(
        z, w_dw[:, None, :].astype(z.dtype), window_strides=(1,),
        padding=[(CONV_W // 2, CONV_W // 2)],
        dimension_numbers=('NWC', 'WIO', 'NWC'), feature_group_count=CONV_CH) + b_dw
    return jax.nn.silu(layer_norm(z, ln_g, ln_b))


def mla_conv_mixer(h, hc, w_in, q_norm_g, w_uq, kv_norm_g, w_ukv, q_g, k_g,
                   w_dw, b_dw, ln_g, ln_b, w_out, ctx_out):
    S = h.shape[1]
    splits = [Q_LORA, Q_LORA + KV_LORA, Q_LORA + KV_LORA + ROPE_DIM]
    q_lat, kv_lat, kr_lat, glu_lat = jnp.split(h @ w_in, splits, axis=-1)
    rope = axial_rope(S, h.dtype)
    q = mla_queries(q_lat, q_norm_g, w_uq, q_g, rope)
    k, v = mla_keys_values(kv_lat, kr_lat, kv_norm_g, w_ukv, k_g, rope)
    if ctx_out:
        q_c_lat, kv_c, kr_c, glu_c = jnp.split(hc @ w_in, splits, axis=-1)
    else:
        kv_c, kr_c = jnp.split(hc @ w_in[:, Q_LORA:Q_LORA + KV_LORA + ROPE_DIM], [KV_LORA], axis=-1)
    k_c, v_c = mla_keys_values(kv_c, kr_c, kv_norm_g, w_ukv, k_g, None)
    k_all = jnp.concatenate([k_c, k], axis=1)
    v_all = jnp.concatenate([v_c, v], axis=1)
    attn = latent_attention(q, k_all, v_all)
    conv = conformer_conv(glu_lat, w_dw, b_dw, ln_g, ln_b)
    y = jnp.concatenate([attn, conv], axis=-1) @ w_out
    if not ctx_out:
        return y, None
    q_c = mla_queries(q_c_lat, q_norm_g, w_uq, q_g, None)
    attn_c = attend(q_c, k_c, v_c).reshape(hc.shape[0], hc.shape[1], N_HEADS * V_DIM)
    conv_c = conformer_conv(glu_c, w_dw, b_dw, ln_g, ln_b)
    yc = jnp.concatenate([attn_c, conv_c], axis=-1) @ w_out
    return y, yc


def chunk_gating_mlp(h, w_in, b_in, ln_g, ln_b, w_s, b_s, w_out):
    B, N, _ = h.shape
    z = jax.nn.gelu(h @ w_in + b_in)
    u, v = jnp.split(z, 2, axis=-1)
    v = layer_norm(v, ln_g, ln_b).reshape(B, N // CHUNK, CHUNK, SG_GROUPS, SG_CH)
    s = jnp.einsum('gpq,bnqgc->bnpgc', w_s, v) + b_s.T[:, :, None]
    return (u * s.reshape(B, N, SG_DIM)) @ w_out


def hier_moe(h, w_group, b_group, w_router, b_router, w_gate, w_up, w_down):
    shp = h.shape
    t = h.reshape(-1, shp[-1])
    gl = (t @ w_group + b_group).astype(jnp.float32)
    gp = jax.nn.softmax(gl, axis=-1)
    gidx = jnp.argmax(gl, axis=-1)
    gw = jnp.take_along_axis(gp, gidx[:, None], axis=-1)
    el = (jnp.einsum('td,gde->tge', t, w_router) + b_router).astype(jnp.float32)
    el = jnp.take_along_axis(el, gidx[:, None, None], axis=1)[:, 0]
    tv, ti = lax.top_k(el, TOP_K)
    ew = jax.nn.softmax(tv, axis=-1) * gw
    eid = gidx[:, None] * EXPERTS_PER_GROUP + ti
    dense_w = jnp.sum(jax.nn.one_hot(eid, N_EXPERTS, dtype=jnp.float32) * ew[..., None], axis=1)
    dense_w = dense_w.astype(t.dtype)
    out = jnp.zeros_like(t)
    for e in range(N_EXPERTS):
        he = (jax.nn.silu(t @ w_gate[e]) * (t @ w_up[e])) @ w_down[e]
        out = out + dense_w[:, e:e + 1] * he
    return out.reshape(shp)


def setup_inputs(seed: int = 0) -> dict:
    key = jax.random.key(seed)
    ks = iter(jax.random.split(key, 40))

    def nrm(shape, scale):
        return jax.random.normal(next(ks), shape, jnp.float32) * scale

    def gain(shape):
        return 1.0 + nrm(shape, 0.02)

    D = D_MODEL
    NE, NO = N_EVEN, N_ODD
    return {
        "x": nrm((BATCH, SEQ, D), 1.0),
        "c": nrm((BATCH, D), 1.0),
        "ctx": nrm((BATCH, CTX_LEN, D), 1.0),
        "c_ctx": nrm((D,), 1.0),
        "w_ada": nrm((DEPTH, D, 6 * D), 0.5 * D ** -0.5),
        "b_ada": nrm((DEPTH, 6 * D), 0.02),
        "norm1_g": gain((DEPTH, D)),
        "norm2_g": gain((DEPTH, D)),
        "a_w_in": nrm((NE, D, A_IN), D ** -0.5),
        "a_q_norm_g": gain((NE, Q_LORA)),
        "a_w_uq": nrm((NE, Q_LORA, N_HEADS * QK_DIM), Q_LORA ** -0.5),
        "a_kv_norm_g": gain((NE, KV_LORA)),
        "a_w_ukv": nrm((NE, KV_LORA, N_HEADS * (NOPE_DIM + V_DIM)), KV_LORA ** -0.5),
        "a_q_g": gain((NE, QK_DIM)),
        "a_k_g": gain((NE, QK_DIM)),
        "b_w_dw": nrm((NE, CONV_W, CONV_CH), CONV_W ** -0.5),
        "b_b_dw": nrm((NE, CONV_CH), 0.02),
        "b_ln_g": gain((NE, CONV_CH)),
        "b_ln_b": nrm((NE, CONV_CH), 0.02),
        "ab_w_out": nrm((NE, MIX_WIDTH, D), MIX_WIDTH ** -0.5),
        "c_w_in": nrm((NO, D, 2 * SG_DIM), D ** -0.5),
        "c_b_in": nrm((NO, 2 * SG_DIM), 0.02),
        "c_ln_g": gain((NO, SG_DIM)),
        "c_ln_b": nrm((NO, SG_DIM), 0.02),
        "c_w_s": nrm((NO, SG_GROUPS, CHUNK, CHUNK), CHUNK ** -0.5),
        "c_b_s": gain((NO, SG_GROUPS, CHUNK)),
        "c_w_out": nrm((NO, SG_DIM, D), SG_DIM ** -0.5),
        "moe_w_group": nrm((DEPTH, D, N_GROUPS), D ** -0.5),
        "moe_b_group": nrm((DEPTH, N_GROUPS), 0.01),
        "moe_w_router": nrm((DEPTH, N_GROUPS, D, EXPERTS_PER_GROUP), D ** -0.5),
        "moe_b_router": nrm((DEPTH, N_GROUPS, EXPERTS_PER_GROUP), 0.01),
        "moe_w_gate": nrm((DEPTH, N_EXPERTS, D, D_EXPERT), D ** -0.5),
        "moe_w_up": nrm((DEPTH, N_EXPERTS, D, D_EXPERT), D ** -0.5),
        "moe_w_down": nrm((DEPTH, N_EXPERTS, D_EXPERT, D), D_EXPERT ** -0.5),
    }


def reference(x, c, ctx, c_ctx, w_ada, b_ada, norm1_g, norm2_g,
              a_w_in, a_q_norm_g, a_w_uq, a_kv_norm_g, a_w_ukv, a_q_g, a_k_g,
              b_w_dw, b_b_dw, b_ln_g, b_ln_b, ab_w_out,
              c_w_in, c_b_in, c_ln_g, c_ln_b, c_w_s, c_b_s, c_w_out,
              moe_w_group, moe_b_group, moe_w_router, moe_b_router,
              moe_w_gate, moe_w_up, moe_w_down):
    xc = ctx
    silu_c = jax.nn.silu(c)
    silu_cc = jax.nn.silu(c_ctx)
    for l in range(DEPTH):
        i = l // 2
        ctx_later = any(j % 2 == 0 for j in range(l + 1, DEPTH))
        ctx_here = (l % 2 == 0) or ctx_later
        mod = (silu_c @ w_ada[l] + b_ada[l])[:, None, :]
        sh1, sc1, g1, sh2, sc2, g2 = jnp.split(mod, 6, axis=-1)
        h = modulate(rms_norm(x, norm1_g[l]), sh1, sc1)
        hc = None
        if ctx_here:
            mod_c = silu_cc @ w_ada[l] + b_ada[l]
            csh1, csc1, cg1, csh2, csc2, cg2 = jnp.split(mod_c, 6, axis=-1)
            hc = modulate(rms_norm(xc, norm1_g[l]), csh1, csc1)
        if l % 2 == 0:
            y, yc = mla_conv_mixer(h, hc, a_w_in[i], a_q_norm_g[i], a_w_uq[i], a_kv_norm_g[i],
                                   a_w_ukv[i], a_q_g[i], a_k_g[i], b_w_dw[i], b_b_dw[i],
                                   b_ln_g[i], b_ln_b[i], ab_w_out[i], ctx_later)
        else:
            y = chunk_gating_mlp(h, c_w_in[i], c_b_in[i], c_ln_g[i], c_ln_b[i],
                                 c_w_s[i], c_b_s[i], c_w_out[i])
            yc = None
            if ctx_later:
                yc = chunk_gating_mlp(hc, c_w_in[i], c_b_in[i], c_ln_g[i], c_ln_b[i],
                                      c_w_s[i], c_b_s[i], c_w_out[i])
        x = x + g1 * y
        moe_args = (moe_w_group[l], moe_b_group[l], moe_w_router[l], moe_b_router[l],
                    moe_w_gate[l], moe_w_up[l], moe_w_down[l])
        h2 = modulate(rms_norm(x, norm2_g[l]), sh2, sc2)
        x = x + g2 * hier_moe(h2, *moe_args)
        if ctx_later:
            xc = xc + cg1 * yc
            hc2 = modulate(rms_norm(xc, norm2_g[l]), csh2, csc2)
            xc = xc + cg2 * hier_moe(hc2, *moe_args)
    return x
```

```cpp
#include <hip/hip_runtime.h>
#include <cstdint>
#include <cstdio>

namespace nv {
constexpr int D = 1024, B = 16, S = 2048, CTX = 256, NK = CTX + S;
constexpr int H = 8, QL = 384, KVL = 256, NOPE = 64, ROPE = 32, QK = 96, VD = 64;
constexpr int CC = 512, CW = 31, AIN = 1696;
constexpr int SG = 2048, CH = 128, SGG = 8, SGC = 256;
constexpr int NG = 4, EPG = 8, NE = 32, DE = 256;

__device__ __forceinline__ float silu_f(float v) { return v / (1.f + expf(-v)); }
__device__ __forceinline__ float gelu_tanh(float v) { return 0.5f * v * (1.f + tanhf(0.7978845608028654f * (v + 0.044715f * v * v * v))); }

__device__ __forceinline__ float block_sum(float v, float* red) {
#pragma unroll
    for (int o = 32; o >= 1; o >>= 1) v += __shfl_xor(v, o);
    __syncthreads();
    if ((threadIdx.x & 63) == 0) red[threadIdx.x >> 6] = v;
    __syncthreads();
    float t = 0.f;
    for (int i = 0; i < (int)(blockDim.x >> 6); ++i) t += red[i];
    return t;
}

__global__ void k_mod(const float* c, const float* cctx, const float* w_ada, const float* b_ada, float* mod) {
    const int j = blockIdx.x * blockDim.x + threadIdx.x, r = blockIdx.y, l = blockIdx.z;
    const float* cv = (r < 16) ? c + (size_t)r * D : cctx;
    const float* w = w_ada + (size_t)l * D * 6 * D;
    float acc = 0.f;
    for (int k = 0; k < D; ++k) acc += silu_f(cv[k]) * w[(size_t)k * 6 * D + j];
    mod[((size_t)l * 17 + r) * 6 * D + j] = acc + b_ada[(size_t)l * 6 * D + j];
}

__global__ void k_rmsmod(const float* x, const float* g, const float* shift, const float* scale, float* out) {
    __shared__ float red[4];
    const size_t row = blockIdx.x;
    const float* xr = x + row * D;
    float v[4]; float ss = 0.f;
#pragma unroll
    for (int i = 0; i < 4; ++i) { v[i] = xr[threadIdx.x + 256 * i]; ss += v[i] * v[i]; }
    const float tot = block_sum(ss, red);
    const float rstd = 1.f / sqrtf(tot / D + 1e-6f);
#pragma unroll
    for (int i = 0; i < 4; ++i) { const int cidx = threadIdx.x + 256 * i; out[row * D + cidx] = v[i] * rstd * g[cidx] * (1.f + scale[cidx]) + shift[cidx]; }
}

__global__ void k_gemm(const float* A, int lda, const float* Bm, int ldb, float* C, int ldc, int M, int N, int K, const float* bias, int act) {
    __shared__ float As[16][65], Bs[16][65];
    const int tx = threadIdx.x & 15, ty = threadIdx.x >> 4;
    const int m0 = blockIdx.y * 64, n0 = blockIdx.x * 64;
    float acc[4][4] = {};
    for (int k0 = 0; k0 < K; k0 += 16) {
        for (int i = threadIdx.x; i < 64 * 16; i += 256) { const int r = i >> 4, kk = i & 15; As[kk][r] = A[(size_t)(m0 + r) * lda + k0 + kk]; }
        for (int i = threadIdx.x; i < 16 * 64; i += 256) { const int kk = i >> 6, cc = i & 63; Bs[kk][cc] = (n0 + cc < N) ? Bm[(size_t)(k0 + kk) * ldb + n0 + cc] : 0.f; }
        __syncthreads();
#pragma unroll
        for (int kk = 0; kk < 16; ++kk) {
            float a[4], b[4];
#pragma unroll
            for (int i = 0; i < 4; ++i) { a[i] = As[kk][ty * 4 + i]; b[i] = Bs[kk][tx * 4 + i]; }
#pragma unroll
            for (int i = 0; i < 4; ++i)
#pragma unroll
                for (int j = 0; j < 4; ++j) acc[i][j] += a[i] * b[j];
        }
        __syncthreads();
    }
#pragma unroll
    for (int i = 0; i < 4; ++i)
#pragma unroll
        for (int j = 0; j < 4; ++j) { const int m = m0 + ty * 4 + i, n = n0 + tx * 4 + j; if (n < N) { float v = acc[i][j] + (bias ? bias[n] : 0.f); if (act == 1) v = gelu_tanh(v); C[(size_t)m * ldc + n] = v; } }
}

__global__ void k_rms_rows(const float* in, int ldi, const float* g, float* out, int ldo, int n, int rows) {
    const int row = blockIdx.x * 4 + (threadIdx.x >> 6), lane = threadIdx.x & 63;
    if (row >= rows) return;
    float ss = 0.f;
    for (int i = lane; i < n; i += 64) { const float v = in[(size_t)row * ldi + i]; ss += v * v; }
#pragma unroll
    for (int o = 32; o >= 1; o >>= 1) ss += __shfl_xor(ss, o);
    const float rstd = 1.f / sqrtf(ss / n + 1e-6f);
    for (int i = lane; i < n; i += 64) out[(size_t)row * ldo + i] = in[(size_t)row * ldi + i] * rstd * g[i];
}

__device__ __forceinline__ void rope_cs(int pos, int j, float& cs, float& sn) {
    const float p = (j < 8) ? (float)(pos / 64) : (float)(pos % 64);
    const float inv = powf(10000.f, -(float)(j & 7) / 8.f);
    const float ang = p * inv; cs = cosf(ang); sn = sinf(ang);
}

__global__ void k_qprep(const float* qraw, const float* qg, float* Q) {
    const int idx = blockIdx.x * blockDim.x + threadIdx.x; if (idx >= S * H) return;
    const int s = idx / H, h = idx % H;
    const float* q = qraw + (size_t)s * 768 + h * 96;
    float ss = 0.f; for (int i = 0; i < 96; ++i) ss += q[i] * q[i];
    const float rstd = 1.f / sqrtf(ss / 96.f + 1e-6f);
    float* o = Q + ((size_t)s * H + h) * 96;
    for (int i = 0; i < 64; ++i) o[i] = q[i] * rstd * qg[i];
    for (int j = 0; j < 16; ++j) { float cs, sn; rope_cs(s, j, cs, sn); const float x1 = q[64 + j] * rstd * qg[64 + j], x2 = q[80 + j] * rstd * qg[80 + j];
        o[64 + j] = x1 * cs - x2 * sn; o[80 + j] = x1 * sn + x2 * cs; }
}
__global__ void k_kprep(const float* kv, const float* kr, int ldkr, const float* kg, float* Kb, float* Vb) {
    const int idx = blockIdx.x * blockDim.x + threadIdx.x; if (idx >= NK * H) return;
    const int r = idx / H, h = idx % H;
    const float* kn = kv + (size_t)r * 1024 + h * 128; const float* krr = kr + (size_t)r * ldkr;
    float ss = 0.f; for (int i = 0; i < 64; ++i) ss += kn[i] * kn[i]; for (int i = 0; i < 32; ++i) ss += krr[i] * krr[i];
    const float rstd = 1.f / sqrtf(ss / 96.f + 1e-6f);
    float* o = Kb + ((size_t)r * H + h) * 96;
    for (int i = 0; i < 64; ++i) o[i] = kn[i] * rstd * kg[i];
    for (int j = 0; j < 16; ++j) { const float x1 = krr[j] * rstd * kg[64 + j], x2 = krr[16 + j] * rstd * kg[80 + j];
        if (r >= CTX) { float cs, sn; rope_cs(r - CTX, j, cs, sn); o[64 + j] = x1 * cs - x2 * sn; o[80 + j] = x1 * sn + x2 * cs; } else { o[64 + j] = x1; o[80 + j] = x2; } }
    float* vo = Vb + ((size_t)r * H + h) * 64;
    for (int i = 0; i < 64; ++i) vo[i] = kn[64 + i];
}
__global__ void k_attn(const float* Q, const float* Kb, const float* Vb, float* concat) {
    __shared__ float p[NK]; __shared__ float qs[96];
    const int s = blockIdx.x / H, h = blockIdx.x % H, lane = threadIdx.x;
    for (int i = lane; i < 96; i += 64) qs[i] = Q[((size_t)s * H + h) * 96 + i];
    __syncthreads();
    float mx = -1e30f;
    for (int k = lane; k < NK; k += 64) { const float* kr = Kb + ((size_t)k * H + h) * 96; float d = 0.f; for (int i = 0; i < 96; ++i) d += qs[i] * kr[i]; d *= 0.10206207261596577f; p[k] = d; mx = fmaxf(mx, d); }
#pragma unroll
    for (int o = 32; o >= 1; o >>= 1) mx = fmaxf(mx, __shfl_xor(mx, o));
    float sum = 0.f;
    for (int k = lane; k < NK; k += 64) { const float e = expf(p[k] - mx); p[k] = e; sum += e; }
#pragma unroll
    for (int o = 32; o >= 1; o >>= 1) sum += __shfl_xor(sum, o);
    __syncthreads();
    float acc = 0.f;
    for (int k = 0; k < NK; ++k) acc += p[k] * Vb[((size_t)k * H + h) * 64 + lane];
    concat[(size_t)s * 1024 + h * 64 + lane] = acc / sum;
}
__global__ void k_glu(const float* glu, int ldg, float* z) {
    const int idx = blockIdx.x * blockDim.x + threadIdx.x; if (idx >= S * CC) return;
    const int t = idx / CC, ch = idx % CC; const float a = glu[(size_t)t * ldg + ch], b = glu[(size_t)t * ldg + CC + ch];
    z[idx] = a / (1.f + expf(-b));
}
__global__ void k_conv(const float* z, const float* wdw, const float* bdw, float* cv) {
    const int idx = blockIdx.x * blockDim.x + threadIdx.x; if (idx >= S * CC) return;
    const int t = idx / CC, ch = idx % CC; float acc = bdw[ch];
    for (int w = 0; w < CW; ++w) { const int tt = t + w - CW / 2; if (tt >= 0 && tt < S) acc += z[(size_t)tt * CC + ch] * wdw[w * CC + ch]; }
    cv[idx] = acc;
}
__global__ void k_ln(const float* in, int ldi, const float* g, const float* b, float* out, int ldo, int n, int do_silu) {
    __shared__ float red[4];
    const size_t row = blockIdx.x;
    float s = 0.f; for (int i = threadIdx.x; i < n; i += 256) s += in[row * ldi + i];
    const float mean = block_sum(s, red) / n;
    float q = 0.f; for (int i = threadIdx.x; i < n; i += 256) { const float d = in[row * ldi + i] - mean; q += d * d; }
    const float var = block_sum(q, red) / n; const float rstd = 1.f / sqrtf(var + 1e-5f);
    for (int i = threadIdx.x; i < n; i += 256) { float v = (in[row * ldi + i] - mean) * rstd * g[i] + b[i]; if (do_silu) v = silu_f(v); out[row * ldo + i] = v; }
}
__global__ void k_resid(const float* xi, const float* gate, const float* y, float* xo, int n) {
    const int idx = blockIdx.x * blockDim.x + threadIdx.x; if (idx >= n) return;
    xo[idx] = xi[idx] + gate[idx % D] * y[idx];
}
__global__ void k_route(const float* h2, const float* wg, const float* bg, const float* wr, const float* br, int* route) {
    const int t = blockIdx.x, lane = threadIdx.x;
    const float* tr = h2 + (size_t)t * D;
    float gl[4], el[32];
#pragma unroll
    for (int g = 0; g < 4; ++g) { float a = 0.f; for (int d = lane; d < D; d += 64) a += tr[d] * wg[d * NG + g];
#pragma unroll
        for (int o = 32; o >= 1; o >>= 1) a += __shfl_xor(a, o); gl[g] = a + bg[g]; }
#pragma unroll
    for (int ge = 0; ge < 32; ++ge) { const int g = ge >> 3, e = ge & 7; float a = 0.f; for (int d = lane; d < D; d += 64) a += tr[d] * wr[((size_t)g * D + d) * EPG + e];
#pragma unroll
        for (int o = 32; o >= 1; o >>= 1) a += __shfl_xor(a, o); el[ge] = a + br[g * EPG + e]; }
    if (lane == 0) {
        int gi = 0; float gm = gl[0];
#pragma unroll
        for (int g = 1; g < 4; ++g) if (gl[g] > gm) { gm = gl[g]; gi = g; }
        float gs = 0.f;
#pragma unroll
        for (int g = 0; g < 4; ++g) gs += expf(gl[g] - gm);
        const float gw = 1.f / gs;
        float v0 = -1e30f, v1 = -1e30f; int i0 = 0, i1 = 0;
#pragma unroll
        for (int ge = 0; ge < 32; ++ge) { if ((ge >> 3) == gi) { const float v = el[ge]; const int e = ge & 7; if (v > v0) { v1 = v0; i1 = i0; v0 = v; i0 = e; } else if (v > v1) { v1 = v; i1 = e; } } }
        const float e1 = expf(v1 - v0); const float w0 = gw / (1.f + e1), w1 = gw * e1 / (1.f + e1);
        route[t * 4 + 0] = gi * EPG + i0; route[t * 4 + 1] = gi * EPG + i1; route[t * 4 + 2] = __float_as_int(w0); route[t * 4 + 3] = __float_as_int(w1);
    }
}
__global__ void k_moe(const float* h2, const int* route, const float* wgate, const float* wup, const float* wdown, const float* xi, const float* g2, float* xo) {
    __shared__ float ts[D]; __shared__ float act[DE];
    const int t = blockIdx.x, j = threadIdx.x;
    for (int i = j; i < D; i += 256) ts[i] = h2[(size_t)t * D + i];
    __syncthreads();
    float acc[4] = {0.f, 0.f, 0.f, 0.f};
    for (int k = 0; k < 2; ++k) {
        const int e = route[t * 4 + k]; const float w = __int_as_float(route[t * 4 + 2 + k]);
        const float* wgp = wgate + (size_t)e * D * DE; const float* wup_ = wup + (size_t)e * D * DE; const float* wd = wdown + (size_t)e * DE * D;
        float ga = 0.f, ua = 0.f;
        for (int d = 0; d < D; ++d) { ga += ts[d] * wgp[(size_t)d * DE + j]; ua += ts[d] * wup_[(size_t)d * DE + j]; }
        __syncthreads();
        act[j] = silu_f(ga) * ua;
        __syncthreads();
#pragma unroll
        for (int i = 0; i < 4; ++i) { float a = 0.f; for (int jj = 0; jj < DE; ++jj) a += act[jj] * wd[(size_t)jj * D + j + 256 * i]; acc[i] += w * a; }
    }
#pragma unroll
    for (int i = 0; i < 4; ++i) { const int n = j + 256 * i; xo[(size_t)t * D + n] = xi[(size_t)t * D + n] + g2[n] * acc[i]; }
}
__global__ void k_spatial(const float* z, const float* vn, const float* ws_, const float* bs, float* us) {
    const int idx = blockIdx.x * blockDim.x + threadIdx.x; if (idx >= S * SG) return;
    const int tok = idx / SG, ch = idx % SG, n = tok / CH, p = tok % CH, g = ch / SGC;
    float a = bs[g * CH + p];
    const float* w = ws_ + ((size_t)g * CH + p) * CH;
    for (int q = 0; q < CH; ++q) a += w[q] * vn[(size_t)(n * CH + q) * SG + ch];
    us[idx] = z[(size_t)tok * 4096 + ch] * a;
}
}

extern "C" void kernel_launch(void* const* d_in, const int* in_sizes, int n_in, void* d_out, int out_size, void* d_ws, size_t ws_size, hipStream_t stream) {
    using namespace nv;
    const float* x = (const float*)d_in[0]; const float* c = (const float*)d_in[1]; const float* ctx = (const float*)d_in[2]; const float* cctx = (const float*)d_in[3];
    const float* w_ada = (const float*)d_in[4]; const float* b_ada = (const float*)d_in[5]; const float* n1g = (const float*)d_in[6]; const float* n2g = (const float*)d_in[7];
    const float* a_w_in = (const float*)d_in[8]; const float* a_qng = (const float*)d_in[9]; const float* a_w_uq = (const float*)d_in[10]; const float* a_kvng = (const float*)d_in[11];
    const float* a_w_ukv = (const float*)d_in[12]; const float* a_qg = (const float*)d_in[13]; const float* a_kg = (const float*)d_in[14];
    const float* b_w_dw = (const float*)d_in[15]; const float* b_b_dw = (const float*)d_in[16]; const float* b_ln_g = (const float*)d_in[17]; const float* b_ln_b = (const float*)d_in[18];
    const float* ab_w_out = (const float*)d_in[19]; const float* c_w_in = (const float*)d_in[20]; const float* c_b_in = (const float*)d_in[21]; const float* c_ln_g = (const float*)d_in[22];
    const float* c_ln_b = (const float*)d_in[23]; const float* c_w_s = (const float*)d_in[24]; const float* c_b_s = (const float*)d_in[25]; const float* c_w_out = (const float*)d_in[26];
    const float* m_wg = (const float*)d_in[27]; const float* m_bg = (const float*)d_in[28]; const float* m_wr = (const float*)d_in[29]; const float* m_br = (const float*)d_in[30];
    const float* m_gate = (const float*)d_in[31]; const float* m_up = (const float*)d_in[32]; const float* m_down = (const float*)d_in[33];
    float* out = (float*)d_out;
    float* w = (float*)d_ws; size_t off = 0;
    auto alloc = [&](size_t n) { float* p = w + off; off += (n + 63) & ~(size_t)63; return p; };
    float* mod = alloc((size_t)2 * 17 * 6 * D);
    float* hb = alloc((size_t)NK * D);
    float* proj = alloc((size_t)NK * AIN);
    float* qn = alloc((size_t)S * QL);
    float* kvn = alloc((size_t)NK * KVL);
    float* qraw = alloc((size_t)S * 768);
    float* kvraw = alloc((size_t)NK * 1024);
    float* Qb = alloc((size_t)S * H * 96); float* Kb = alloc((size_t)NK * H * 96); float* Vb = alloc((size_t)NK * H * 64);
    float* concat = alloc((size_t)S * D);
    float* zb = alloc((size_t)S * CC); float* cvb = alloc((size_t)S * CC);
    float* yb = alloc((size_t)S * D);
    float* x1 = alloc((size_t)S * D); float* h2 = alloc((size_t)S * D); float* x2 = alloc((size_t)S * D); float* x3 = alloc((size_t)S * D);
    int* route = (int*)alloc((size_t)S * 4);
    float* z4 = alloc((size_t)S * 4096); float* vn = alloc((size_t)S * SG); float* us = alloc((size_t)S * SG);

    k_mod<<<dim3(6 * D / 256, 17, 2), 256, 0, stream>>>(c, cctx, w_ada, b_ada, mod);
    for (int b = 0; b < B; ++b) {
        const float* xb = x + (size_t)b * S * D; const float* cb = ctx + (size_t)b * CTX * D;
        const float* m0 = mod + ((size_t)0 * 17 + b) * 6 * D; const float* m0c = mod + ((size_t)0 * 17 + 16) * 6 * D; const float* m1 = mod + ((size_t)1 * 17 + b) * 6 * D;
        k_rmsmod<<<CTX, 256, 0, stream>>>(cb, n1g, m0c, m0c + D, hb);
        k_rmsmod<<<S, 256, 0, stream>>>(xb, n1g, m0, m0 + D, hb + (size_t)CTX * D);
        k_gemm<<<dim3((AIN + 63) / 64, NK / 64), 256, 0, stream>>>(hb, D, a_w_in, AIN, proj, AIN, NK, AIN, D, nullptr, 0);
        const float* projl = proj + (size_t)CTX * AIN;
        k_rms_rows<<<S / 4, 256, 0, stream>>>(projl, AIN, a_qng, qn, QL, QL, S);
        k_rms_rows<<<NK / 4, 256, 0, stream>>>(proj + QL, AIN, a_kvng, kvn, KVL, KVL, NK);
        k_gemm<<<dim3(768 / 64, S / 64), 256, 0, stream>>>(qn, QL, a_w_uq, 768, qraw, 768, S, 768, QL, nullptr, 0);
        k_gemm<<<dim3(1024 / 64, NK / 64), 256, 0, stream>>>(kvn, KVL, a_w_ukv, 1024, kvraw, 1024, NK, 1024, KVL, nullptr, 0);
        k_qprep<<<(S * H + 255) / 256, 256, 0, stream>>>(qraw, a_qg, Qb);
        k_kprep<<<(NK * H + 255) / 256, 256, 0, stream>>>(kvraw, proj + QL + KVL, AIN, a_kg, Kb, Vb);
        k_attn<<<S * H, 64, 0, stream>>>(Qb, Kb, Vb, concat);
        k_glu<<<(S * CC + 255) / 256, 256, 0, stream>>>(projl + QL + KVL + ROPE, AIN, zb);
        k_conv<<<(S * CC + 255) / 256, 256, 0, stream>>>(zb, b_w_dw, b_b_dw, cvb);
        k_ln<<<S, 256, 0, stream>>>(cvb, CC, b_ln_g, b_ln_b, concat + 512, D, CC, 1);
        k_gemm<<<dim3(D / 64, S / 64), 256, 0, stream>>>(concat, D, ab_w_out, D, yb, D, S, D, D, nullptr, 0);
        k_resid<<<(S * D + 255) / 256, 256, 0, stream>>>(xb, m0 + 2 * D, yb, x1, S * D);
        k_rmsmod<<<S, 256, 0, stream>>>(x1, n2g, m0 + 3 * D, m0 + 4 * D, h2);
        k_route<<<S, 64, 0, stream>>>(h2, m_wg, m_bg, m_wr, m_br, route);
        k_moe<<<S, 256, 0, stream>>>(h2, route, m_gate, m_up, m_down, x1, m0 + 5 * D, x2);
        k_rmsmod<<<S, 256, 0, stream>>>(x2, n1g + D, m1, m1 + D, hb);
        k_gemm<<<dim3(4096 / 64, S / 64), 256, 0, stream>>>(hb, D, c_w_in, 4096, z4, 4096, S, 4096, D, c_b_in, 1);
        k_ln<<<S, 256, 0, stream>>>(z4 + SG, 4096, c_ln_g, c_ln_b, vn, SG, SG, 0);
        k_spatial<<<(S * SG + 255) / 256, 256, 0, stream>>>(z4, vn, c_w_s, c_b_s, us);
        k_gemm<<<dim3(D / 64, S / 64), 256, 0, stream>>>(us, SG, c_w_out, D, yb, D, S, D, SG, nullptr, 0);
        k_resid<<<(S * D + 255) / 256, 256, 0, stream>>>(x2, m1 + 2 * D, yb, x3, S * D);
        k_rmsmod<<<S, 256, 0, stream>>>(x3, n2g + D, m1 + 3 * D, m1 + 4 * D, h2);
        k_route<<<S, 64, 0, stream>>>(h2, m_wg + (size_t)D * NG, m_bg + NG, m_wr + (size_t)NG * D * EPG, m_br + NG * EPG, route);
        k_moe<<<S, 256, 0, stream>>>(h2, route, m_gate + (size_t)NE * D * DE, m_up + (size_t)NE * D * DE, m_down + (size_t)NE * DE * D, x3, m1 + 5 * D, out + (size_t)b * S * D);
    }
}
```

```cpp
#include <hip/hip_runtime.h>
#include <cstdint>
#include <cstdio>

#define LAS __attribute__((address_space(3)))
#define GAS __attribute__((address_space(1)))
typedef unsigned short bf16_t;
typedef short bf16x8 __attribute__((ext_vector_type(8)));
typedef float f32x4 __attribute__((ext_vector_type(4)));
typedef float f32x2 __attribute__((ext_vector_type(2)));
typedef float f32x16 __attribute__((ext_vector_type(16)));
typedef unsigned u32x4 __attribute__((ext_vector_type(4)));
typedef unsigned u32x2 __attribute__((ext_vector_type(2)));

namespace cfg {
constexpr int D = 1024, NB = 16, S = 2048, CTX = 256, NK = 2304, T = NB * S, TC = NB * CTX, TA = T + TC;
constexpr int H = 8, QL = 384, KVL = 256, AIN = 1696, AINP = 1792;
constexpr int CC = 512, CW = 31, SG = 2048, CH = 128;
constexpr int NE = 32, DE = 256, CAP_TILES = 288;
constexpr float QSCALE = 1.4426950408889634f * 0.10206207261596575f;
constexpr size_t MiB = (size_t)1 << 20;
constexpr size_t OFF_CTL = 0, CTL_BYTES = MiB;
constexpr size_t OFF_MOD = 1 * MiB, OFF_ROPE = 2 * MiB, OFF_RFRAG = 2 * MiB + 512 * 1024, OFF_RBIAS = 3 * MiB - 4096;
constexpr size_t OFF_WIN = 4 * MiB, OFF_WUQ = 7 * MiB + 512 * 1024, OFF_WUKV = 8 * MiB + 256 * 1024, OFF_WOUT = 9 * MiB, OFF_CIN = 11 * MiB, OFF_COUT = 19 * MiB, OFF_WSB = 23 * MiB;
constexpr size_t OFF_MGU = 24 * MiB, OFF_MDN = 88 * MiB;
constexpr size_t OFF_LIST = 120 * MiB, OFF_LISTW = 124 * MiB, OFF_TOKSLOT = 128 * MiB;
constexpr size_t OFF_HB = 132 * MiB, OFF_PROJ = 204 * MiB, OFF_QN = 330 * MiB, OFF_KVN = 354 * MiB, OFF_Z = 377 * MiB;
constexpr size_t OFF_QRAW = 132 * MiB, OFF_KVRAW = 204 * MiB, OFF_Q = 276 * MiB, OFF_K = 324 * MiB, OFF_V = 378 * MiB, OFF_CONCAT = 414 * MiB, OFF_KR = 478 * MiB;
constexpr size_t OFF_H2 = 132 * MiB, OFF_ACT = 196 * MiB, OFF_HE = 232 * MiB, OFF_ZZ = 196 * MiB;
constexpr size_t WS_NEED = 483 * MiB;
static_assert(OFF_MOD + (size_t)2 * 17 * 6144 * 4 <= OFF_ROPE && OFF_ROPE + 2 * 2048 * 16 * 4 <= OFF_RFRAG && OFF_RFRAG + 2 * 32 * 3 * 2 * 1024 <= OFF_RBIAS, "tables");
static_assert(OFF_WIN + (size_t)AINP * 1024 * 2 <= OFF_WUQ && OFF_WUQ + 768 * 384 * 2 <= OFF_WUKV && OFF_WUKV + 1024 * 256 * 2 <= OFF_WOUT && OFF_WOUT + 1024 * 1024 * 2 <= OFF_CIN, "weights 1");
static_assert(OFF_CIN + (size_t)4096 * 1024 * 2 <= OFF_COUT && OFF_COUT + (size_t)1024 * 2048 * 2 <= OFF_WSB && OFF_WSB + 8 * 128 * 128 * 2 <= OFF_MGU, "weights 2");
static_assert(OFF_MGU + (size_t)2 * 32 * 512 * 1024 * 2 <= OFF_MDN && OFF_MDN + (size_t)2 * 32 * 1024 * 256 * 2 <= OFF_LIST && OFF_LIST + (size_t)32 * 32768 * 4 <= OFF_LISTW && OFF_LISTW + (size_t)32 * 32768 * 4 <= OFF_TOKSLOT && OFF_TOKSLOT + (size_t)T * 2 * 4 <= OFF_HB, "moe");
static_assert(OFF_HB + (size_t)TA * 1024 * 2 <= OFF_PROJ && OFF_PROJ + (size_t)TA * AINP * 2 <= OFF_QN && OFF_QN + (size_t)T * 384 * 2 <= OFF_KVN && OFF_KVN + (size_t)TA * 256 * 2 <= OFF_Z && OFF_Z + (size_t)T * 512 * 2 <= OFF_CONCAT, "act 1");
static_assert(OFF_QRAW + (size_t)T * 768 * 2 <= OFF_KVRAW && OFF_KVRAW + (size_t)TA * 1024 * 2 <= OFF_Q && OFF_Q + (size_t)T * 768 * 2 <= OFF_K && OFF_K + (size_t)128 * NK * 96 * 2 <= OFF_V && OFF_V + (size_t)128 * NK * 64 * 2 <= OFF_CONCAT, "act 2");
static_assert(OFF_CONCAT + (size_t)T * 1024 * 2 <= OFF_KR && OFF_KR + (size_t)TA * 32 * 4 <= WS_NEED, "act 3");
static_assert(OFF_H2 + (size_t)T * 1024 * 2 <= OFF_ACT && OFF_ACT + (size_t)CAP_TILES * 256 * 256 * 2 <= OFF_HE && OFF_HE + (size_t)CAP_TILES * 256 * 1024 * 2 <= WS_NEED && OFF_ZZ + (size_t)T * 4096 * 2 <= WS_NEED, "act 4");
constexpr int CW_BAR = 4096, CW_GCNT = 8192;
constexpr int LDS_TB = 131072, LDS_CNT = LDS_TB + 256, LDS_TOKL = LDS_TB + 512, LDS_WL = LDS_TOKL + 4096, LDS_UT = LDS_WL + 4096, LDS_MISC = LDS_UT + 256, LDS_BYTES = 147456;
static_assert(LDS_MISC + 64 <= LDS_BYTES, "lds map");
constexpr int NPHASE = 19;
}
namespace pg8 {
constexpr int BM = 256, BK = 64, HALF = 128, HTB = HALF * BK * 2, STAGE_BYTES = 8 * HTB, NXCD = 8, WGM = 8;
__host__ __device__ __forceinline__ int lds_byte(int r, int c) { const int st = (r >> 4) * 2 + (c >> 5), rr = r & 15, cc = c & 31, ob = rr * 64 + cc * 2; return st * 1024 + (ob ^ (((ob >> 9) & 1) << 5)); }
__host__ __device__ __forceinline__ void stage_rc(int b, int& R, int& C) { const int st = b / 1024, sb = b % 1024, swz = sb ^ (((sb >> 9) & 1) << 5); R = (st >> 1) * 16 + swz / 64; C = (st & 1) * 32 + (swz % 64) / 2; }
__host__ __device__ __forceinline__ int perm32(int rho) { const int n = rho >> 4, i = rho & 15; return 8 * (i >> 2) + 4 * n + (i & 3); }

struct Unit { int pm, pn, eb, aux; };
struct Gemm { const bf16_t* A; const bf16_t* Bt; int lda, ldb, K; size_t bstride; };

struct StaticOrder {
    int nM, nN, nwg, G, c;
    __device__ __forceinline__ void init(int M, int N, int G_, int c_) { nM = M / BM; nN = N / BM; nwg = nM * nN; G = G_; c = c_; }
    __device__ __forceinline__ bool next(int i, Unit& u) const {
        const long L = (long)i * G + c; if (L >= nwg) return false;
        int wgid = (int)L; { const int q = nwg / NXCD, r = nwg % NXCD, xcd = wgid % NXCD, off = wgid / NXCD; wgid = (xcd < r ? xcd * (q + 1) : r * (q + 1) + (xcd - r) * q) + off; }
        const int nig = WGM * nN, gid = wgid / nig, fm = gid * WGM, gsz = (nM - fm) < WGM ? (nM - fm) : WGM;
        u.pm = fm + ((wgid % nig) % gsz); u.pn = (wgid % nig) / gsz; u.eb = 0; u.aux = 0; return true;
    }
};
struct GroupedOrder {
    const volatile LAS int* ut; int n;
    __device__ __forceinline__ bool next(int i, Unit& u) const {
        if (i >= n) return false;
        u.pm = __builtin_amdgcn_readfirstlane(ut[4 * i]); u.pn = __builtin_amdgcn_readfirstlane(ut[4 * i + 1]); u.eb = __builtin_amdgcn_readfirstlane(ut[4 * i + 2]); u.aux = __builtin_amdgcn_readfirstlane(ut[4 * i + 3]); return true;
    }
};
__device__ __forceinline__ void build_units(volatile LAS int* ut, const LAS int* tb, int ncol, int G, int c) {
    const int nunits = tb[32] * ncol; int n = 0;
    for (int i = 0; i < 8; ++i) { const int L = i * G + c; if (L >= nunits) break; const int rt = L / ncol; int e = 0;
        for (int k = 1; k < 32; ++k) if (tb[k] <= rt) e = k;
        ut[4 * i] = rt; ut[4 * i + 1] = L - rt * ncol; ut[4 * i + 2] = e; ut[4 * i + 3] = rt - tb[e]; n = i + 1; }
    ut[32] = n;
}

__device__ __forceinline__ unsigned cvt_pk_bf16(float lo, float hi) { unsigned r; asm volatile("v_cvt_pk_bf16_f32 %0, %1, %2" : "=v"(r) : "v"(lo), "v"(hi)); return r; }
__device__ __forceinline__ float gelu_tanh_f(float v) { const float t = v * (-2.302208198f + -0.1029432397f * v * v); return v * __builtin_amdgcn_rcpf(1.0f + __builtin_amdgcn_exp2f(t)); }

template <int ACT> struct EpiBf16 {
    static constexpr bool PERM = true;
    bf16_t* O; int ldc; const float* bias;
    __device__ __forceinline__ void operator()(const f32x4 (&acc)[2][2][4][2], const Unit& u, int ui, int wr, int wc, int fr, int fq) const {
        const int row0 = u.pm * BM + wr * 64 + fr; const int col0 = u.pn * BM + wc * 32 + 8 * fq;
        f32x4 bv[2][2];
#pragma unroll
        for (int bj = 0; bj < 2; ++bj)
#pragma unroll
            for (int n = 0; n < 2; ++n) bv[bj][n] = bias ? *(const f32x4*)(bias + col0 + bj * HALF + 4 * n) : (f32x4){0.f, 0.f, 0.f, 0.f};
#pragma unroll
        for (int ai = 0; ai < 2; ++ai)
#pragma unroll
            for (int m = 0; m < 4; ++m) { bf16_t* rowp = O + (size_t)(row0 + ai * HALF + m * 16) * ldc + col0;
#pragma unroll
                for (int bj = 0; bj < 2; ++bj) { f32x4 v0 = acc[ai][bj][m][0] + bv[bj][0], v1 = acc[ai][bj][m][1] + bv[bj][1];
                    if (ACT == 1) {
#pragma unroll
                        for (int j = 0; j < 4; ++j) { v0[j] = gelu_tanh_f(v0[j]); v1[j] = gelu_tanh_f(v1[j]); } }
                    u32x4 w; w.x = cvt_pk_bf16(v0[0], v0[1]); w.y = cvt_pk_bf16(v0[2], v0[3]); w.z = cvt_pk_bf16(v1[0], v1[1]); w.w = cvt_pk_bf16(v1[2], v1[3]);
                    *(u32x4*)(rowp + bj * HALF) = w; } }
    }
};
struct EpiResid {
    static constexpr bool PERM = false;
    const float* xi; float* xo; const float* gate; int gstride;
    __device__ __forceinline__ void operator()(const f32x4 (&acc)[2][2][4][2], const Unit& u, int ui, int wr, int wc, int fr, int fq) const {
        const int row0 = u.pm * BM + wr * 64 + fr, col0 = u.pn * BM + wc * 32 + 4 * fq;
        const float* gp = gate + (size_t)((u.pm * BM) >> 11) * gstride + col0;
        f32x4 gv[2][2];
#pragma unroll
        for (int bj = 0; bj < 2; ++bj)
#pragma unroll
            for (int n = 0; n < 2; ++n) gv[bj][n] = *(const f32x4*)(gp + bj * HALF + n * 16);
#pragma unroll
        for (int ai = 0; ai < 2; ++ai)
#pragma unroll
            for (int m = 0; m < 4; ++m) { const size_t off = (size_t)(row0 + ai * HALF + m * 16) * 1024 + col0;
#pragma unroll
                for (int bj = 0; bj < 2; ++bj)
#pragma unroll
                    for (int n = 0; n < 2; ++n) { const f32x4 xv = *(const f32x4*)(xi + off + bj * HALF + n * 16); *(f32x4*)(xo + off + bj * HALF + n * 16) = xv + gv[bj][n] * acc[ai][bj][m][n]; } }
    }
};
struct EpiAct {
    static constexpr bool PERM = false;
    bf16_t* O; const LAS float* wl;
    __device__ __forceinline__ void operator()(const f32x4 (&acc)[2][2][4][2], const Unit& u, int ui, int wr, int wc, int fr, int fq) const {
        const int col0 = u.pn * HALF + wc * 32 + 4 * fq;
#pragma unroll
        for (int ai = 0; ai < 2; ++ai)
#pragma unroll
            for (int m = 0; m < 4; ++m) { const int rt = ai * HALF + wr * 64 + m * 16 + fr; const float w = wl[ui * 256 + rt];
                bf16_t* rowp = O + (size_t)(u.pm * BM + rt) * 256 + col0;
#pragma unroll
                for (int n = 0; n < 2; ++n) { const f32x4 g = acc[ai][0][m][n], up = acc[ai][1][m][n]; f32x4 r;
#pragma unroll
                    for (int j = 0; j < 4; ++j) r[j] = w * up[j] * g[j] * __builtin_amdgcn_rcpf(1.0f + __builtin_amdgcn_exp2f(-1.4426950409f * g[j]));
                    u32x2 o; o.x = cvt_pk_bf16(r[0], r[1]); o.y = cvt_pk_bf16(r[2], r[3]); *(u32x2*)(rowp + n * 16) = o; } }
    }
};

template <class Epi, class Sched, bool GATHER>
__device__ __forceinline__ void gemm_phase(LAS unsigned char* lds, const Gemm g, const Sched& S, const Epi& E, const LAS int* tokl) {
    const int tid = threadIdx.x, wid = __builtin_amdgcn_readfirstlane(tid >> 6), lane = tid & 63, wr = wid >> 2, wc = wid & 3, fr = lane & 15, fq = lane >> 4;
    const int K = g.K, nt = K / BK;
    const size_t kstep = (size_t)(BK * 2);
    const size_t hstepB = (size_t)HALF * g.ldb * 2, tstepB = 2 * hstepB;
    const unsigned hstepA = (unsigned)HALF * g.lda * 2; const size_t tstepA = 2 * (size_t)hstepA;
    int Rs[2], Cs[2]; unsigned voffB[2];
#pragma unroll
    for (int i = 0; i < 2; ++i) { int R, C; stage_rc(tid * 16 + i * 8192, R, C); Rs[i] = R; Cs[i] = C; const int Rb = Epi::PERM ? ((R & ~31) + perm32(R & 31)) : R; voffB[i] = (unsigned)(Rb * g.ldb + C) * 2u; }
    unsigned offA[2][2], noffA[2][2];
#define PG8_SETOFF(dst, UI) do { _Pragma("unroll") for (int _h = 0; _h < 2; ++_h) _Pragma("unroll") for (int _i = 0; _i < 2; ++_i) { \
        if (GATHER) dst[_h][_i] = (unsigned)tokl[(UI) * 256 + _h * HALF + Rs[_i]] * (unsigned)(g.lda * 2) + (unsigned)Cs[_i] * 2u; \
        else dst[_h][_i] = (unsigned)_h * hstepA + (unsigned)(Rs[_i] * g.lda + Cs[_i]) * 2u; } } while (0)
    const unsigned ldsw = (unsigned)wid * 1024u;
    const int aoff = lds_byte(wr * 64 + fr, fq * 8), boff = lds_byte(wc * 32 + fr, fq * 8);
#define PG8_SA(b, h) (((b) * 2 + (h)) * HTB)
#define PG8_SB(b, h) ((4 + (b) * 2 + (h)) * HTB)
#define PG8_STAGE(bufoff, gbase, voff) do { _Pragma("unroll") for (int _i = 0; _i < 2; ++_i) \
        __builtin_amdgcn_global_load_lds((const unsigned*)((const char*)(gbase) + (voff)[_i]), (LAS unsigned*)(lds + (bufoff) + ldsw + _i * 8192), 16, 0, 0); } while (0)
#define PG8_LDA(dst, b, h) do { _Pragma("unroll") for (int m = 0; m < 4; ++m) _Pragma("unroll") for (int k = 0; k < 2; ++k) dst[m][k] = *(const LAS bf16x8*)(lds + PG8_SA(b, h) + aoff + m * 2048 + k * 1024); } while (0)
#define PG8_LDB(dst, b, h) do { _Pragma("unroll") for (int n = 0; n < 2; ++n) _Pragma("unroll") for (int k = 0; k < 2; ++k) dst[n][k] = *(const LAS bf16x8*)(lds + PG8_SB(b, h) + boff + n * 2048 + k * 1024); } while (0)
#define PG8_MMA(ai, bj, At, Bt) do { __builtin_amdgcn_s_setprio(1); _Pragma("unroll") for (int m = 0; m < 4; ++m) _Pragma("unroll") for (int n = 0; n < 2; ++n) _Pragma("unroll") for (int k = 0; k < 2; ++k) \
        acc[ai][bj][m][n] = __builtin_amdgcn_mfma_f32_16x16x32_bf16(Bt[n][k], At[m][k], acc[ai][bj][m][n], 0, 0, 0); __builtin_amdgcn_s_setprio(0); } while (0)
#define PG8_WAIT_V(n) asm volatile("s_waitcnt vmcnt(" #n ")" ::: "memory")
#define PG8_WAIT_L(n) asm volatile("s_waitcnt lgkmcnt(" #n ")" ::: "memory")
#define PG8_BAR __builtin_amdgcn_s_barrier()
#define PG8_SCHED __builtin_amdgcn_sched_barrier(0)
    Unit cur, nxt; int ui = 0;
    if (!S.next(0, cur)) return;
    f32x4 acc[2][2][4][2];
#pragma unroll
    for (int a = 0; a < 2; ++a)
#pragma unroll
        for (int b = 0; b < 2; ++b)
#pragma unroll
            for (int m = 0; m < 4; ++m)
#pragma unroll
                for (int n = 0; n < 2; ++n) acc[a][b][m][n] = (f32x4){0.f, 0.f, 0.f, 0.f};
    bf16x8 At[4][2], B0[2][2], B1[2][2];
    const char* cA = GATHER ? (const char*)g.A : (const char*)g.A + (size_t)cur.pm * tstepA;
    const char* cB = (const char*)g.Bt + ((size_t)cur.eb * g.bstride) * 2 + (size_t)cur.pn * tstepB;
    PG8_SETOFF(offA, 0);
#pragma unroll
    for (int _h = 0; _h < 2; ++_h)
#pragma unroll
        for (int _i = 0; _i < 2; ++_i) noffA[_h][_i] = offA[_h][_i];
    PG8_STAGE(PG8_SB(0, 0), cB, voffB); PG8_STAGE(PG8_SB(0, 1), cB + hstepB, voffB); PG8_STAGE(PG8_SA(0, 0), cA, offA[0]); PG8_STAGE(PG8_SA(0, 1), cA, offA[1]);
    if (wr == 1) PG8_BAR;
    PG8_WAIT_V(2); PG8_BAR;
    PG8_STAGE(PG8_SB(1, 0), cB + kstep, voffB); PG8_STAGE(PG8_SA(1, 0), cA + kstep, offA[0]); PG8_STAGE(PG8_SB(1, 1), cB + hstepB + kstep, voffB);
    PG8_WAIT_V(6); PG8_BAR;
    for (;;) {
        const bool has_next = S.next(ui + 1, nxt);
        const char* nA = has_next ? (GATHER ? (const char*)g.A : (const char*)g.A + (size_t)nxt.pm * tstepA) : cA;
        const char* nB = has_next ? (const char*)g.Bt + ((size_t)nxt.eb * g.bstride) * 2 + (size_t)nxt.pn * tstepB : cB;
        if (GATHER && has_next) PG8_SETOFF(noffA, ui + 1);
#pragma unroll 1
        for (int t = 0; t < nt; t += 2) {
            const bool last = (t == nt - 2);
            const char* a1 = cA + (size_t)(t + 1) * kstep;
            const char* a2 = last ? nA : cA + (size_t)(t + 2) * kstep; const char* b2 = last ? nB : cB + (size_t)(t + 2) * kstep;
            const char* a3 = a2 + kstep; const char* b3 = b2 + kstep;
            unsigned o2[2][2];
#pragma unroll
            for (int _h = 0; _h < 2; ++_h)
#pragma unroll
                for (int _i = 0; _i < 2; ++_i) o2[_h][_i] = (GATHER && last) ? noffA[_h][_i] : offA[_h][_i];
            PG8_LDB(B0, 0, 0); PG8_LDB(B1, 0, 1); PG8_SCHED; PG8_LDA(At, 0, 0); PG8_STAGE(PG8_SA(1, 1), a1, offA[1]);
            PG8_WAIT_V(8); PG8_WAIT_L(0); PG8_BAR; PG8_MMA(0, 0, At, B0); PG8_MMA(0, 1, At, B1); PG8_BAR; PG8_SCHED;
            PG8_LDA(At, 0, 1); PG8_STAGE(PG8_SB(0, 0), b2, voffB); PG8_STAGE(PG8_SB(0, 1), b2 + hstepB, voffB); PG8_STAGE(PG8_SA(0, 0), a2, o2[0]);
            PG8_WAIT_V(8); PG8_WAIT_L(0); PG8_BAR; PG8_MMA(1, 0, At, B0); PG8_MMA(1, 1, At, B1); PG8_BAR; PG8_SCHED;
            PG8_LDB(B0, 1, 0); PG8_LDB(B1, 1, 1); PG8_SCHED; PG8_LDA(At, 1, 0); PG8_STAGE(PG8_SA(0, 1), a2, o2[1]);
            PG8_WAIT_V(8); PG8_WAIT_L(0); PG8_BAR; PG8_MMA(0, 0, At, B0); PG8_MMA(0, 1, At, B1); PG8_BAR; PG8_SCHED;
            PG8_LDA(At, 1, 1); PG8_STAGE(PG8_SB(1, 0), b3, voffB); PG8_STAGE(PG8_SB(1, 1), b3 + hstepB, voffB); PG8_STAGE(PG8_SA(1, 0), a3, o2[0]);
            PG8_WAIT_V(8); PG8_WAIT_L(0); PG8_BAR; PG8_MMA(1, 0, At, B0); PG8_MMA(1, 1, At, B1); PG8_BAR; PG8_SCHED;
        }
        if (wr == 0) PG8_BAR;
        E(acc, cur, ui, wr, wc, fr, fq);
        if (!has_next) break;
#pragma unroll
        for (int a = 0; a < 2; ++a)
#pragma unroll
            for (int b = 0; b < 2; ++b)
#pragma unroll
                for (int m = 0; m < 4; ++m)
#pragma unroll
                    for (int n = 0; n < 2; ++n) acc[a][b][m][n] = (f32x4){0.f, 0.f, 0.f, 0.f};
        cur = nxt; cA = nA; cB = nB; ++ui;
        if (GATHER) {
#pragma unroll
            for (int _h = 0; _h < 2; ++_h)
#pragma unroll
                for (int _i = 0; _i < 2; ++_i) offA[_h][_i] = noffA[_h][_i]; }
        if (wr == 1) PG8_BAR;
    }
    PG8_WAIT_V(0);
    PG8_BAR;
#undef PG8_SETOFF
#undef PG8_SA
#undef PG8_SB
#undef PG8_STAGE
#undef PG8_LDA
#undef PG8_LDB
#undef PG8_MMA
#undef PG8_WAIT_V
#undef PG8_WAIT_L
#undef PG8_BAR
#undef PG8_SCHED
}
}
namespace att {
constexpr int NKEY = 2304, KT = 64, NT = NKEY / KT, KSLOT = 12288, VSLOT = 8192;
constexpr int LDS_K = 0, LDS_V = 2 * KSLOT, LDS_WS = LDS_V + 2 * VSLOT, LDS_BYTES = LDS_WS + 8 * 256;
__device__ __forceinline__ int crow(int r, int hi) { return (r & 3) + 8 * (r >> 2) + 4 * hi; }
typedef short s16x4 __attribute__((ext_vector_type(4)));
__device__ __forceinline__ unsigned cvtpk(float lo, float hi) { unsigned r; asm volatile("v_cvt_pk_bf16_f32 %0, %1, %2" : "=v"(r) : "v"(lo), "v"(hi)); return r; }

__device__ __forceinline__ void attn_unit(int bh, int qb, const bf16_t* Q, const bf16_t* K, const bf16_t* V, bf16_t* concat, LAS unsigned char* lds) {
    const int tid = threadIdx.x, lane = tid & 63, r32 = lane & 31, hi = lane >> 5; const int wid = __builtin_amdgcn_readfirstlane(tid >> 6);
    const bf16_t* Qw = Q + ((size_t)bh * 2048 + qb * 256 + wid * 32) * 96;
    const bf16_t* Kh = K + (size_t)bh * NKEY * 96; const bf16_t* Vh = V + (size_t)bh * NKEY * 64;
    LAS float* wsf = (LAS float*)(lds + LDS_WS) + wid * 64;
    const bf16_t* ksrc0 = Kh + (size_t)lane * 96 + wid * 8;
    const bf16_t* ksrc1 = Kh + (size_t)lane * 96 + (8 + (wid & 3)) * 8;
    const bf16_t* vsrc = Vh + (size_t)(16 * (wid & 3) + (lane >> 2)) * 64 + (wid >> 2) * 32 + (lane & 3) * 8;
#define ATT_DMA(t, slot) do { \
        __builtin_amdgcn_global_load_lds((const unsigned*)(ksrc0 + (size_t)(t) * KT * 96), (LAS unsigned*)(lds + LDS_K + (slot) * KSLOT + wid * 1024), 16, 0, 0); \
        if (wid < 4) __builtin_amdgcn_global_load_lds((const unsigned*)(ksrc1 + (size_t)(t) * KT * 96), (LAS unsigned*)(lds + LDS_K + (slot) * KSLOT + (8 + wid) * 1024), 16, 0, 0); \
        __builtin_amdgcn_global_load_lds((const unsigned*)(vsrc + (size_t)(t) * KT * 64), (LAS unsigned*)(lds + LDS_V + (slot) * VSLOT + wid * 1024), 16, 0, 0); } while (0)
    ATT_DMA(0, 0);
    bf16x8 qr[6];
#pragma unroll
    for (int d0 = 0; d0 < 6; ++d0) qr[d0] = *(const bf16x8*)(Qw + (size_t)r32 * 96 + d0 * 16 + hi * 8);
    float m_run = -1e30f, l_run = 0.f; f32x16 o[2]; o[0] = (f32x16){}; o[1] = (f32x16){};
    const int kfo = hi * 1024 + r32 * 16;
    const int vfo = ((lane >> 4) & 1) * 32 + (lane & 3) * 8 + (4 * hi + ((lane & 15) >> 2)) * 64;
#pragma unroll 1
    for (int t = 0; t < NT; ++t) {
        asm volatile("s_waitcnt vmcnt(0)\n\ts_barrier" ::: "memory");
        const int slot = t & 1;
        if (t + 1 < NT) ATT_DMA(t + 1, slot ^ 1);
        const LAS unsigned char* kb = lds + LDS_K + slot * KSLOT + kfo;
        f32x16 p0 = (f32x16){}, p1 = (f32x16){};
#pragma unroll
        for (int d0 = 0; d0 < 6; ++d0) {
            const bf16x8 k0 = *(const LAS bf16x8*)(kb + d0 * 2048);
            const bf16x8 k1 = *(const LAS bf16x8*)(kb + d0 * 2048 + 512);
            p0 = __builtin_amdgcn_mfma_f32_32x32x16_bf16(k0, qr[d0], p0, 0, 0, 0);
            p1 = __builtin_amdgcn_mfma_f32_32x32x16_bf16(k1, qr[d0], p1, 0, 0, 0);
        }
        float mx = p0[0];
#pragma unroll
        for (int r = 1; r < 16; ++r) mx = fmaxf(mx, p0[r]);
#pragma unroll
        for (int r = 0; r < 16; ++r) mx = fmaxf(mx, p1[r]);
        mx = fmaxf(mx, __shfl_xor(mx, 32));
        const float m_new = fmaxf(m_run, mx);
        const float alpha = __builtin_amdgcn_exp2f(m_run - m_new);
        const bool changed = !__all(m_new == m_run);
        m_run = m_new;
        float ls = 0.f;
#pragma unroll
        for (int r = 0; r < 16; ++r) { p0[r] = __builtin_amdgcn_exp2f(p0[r] - m_new); p1[r] = __builtin_amdgcn_exp2f(p1[r] - m_new); ls += p0[r] + p1[r]; }
        l_run = l_run * alpha + ls;
        if (changed) {
            if (hi == 0) wsf[r32] = alpha;
            asm volatile("s_waitcnt lgkmcnt(0)" ::: "memory");
#pragma unroll
            for (int r = 0; r < 16; ++r) { const float a = wsf[crow(r, hi)]; o[0][r] *= a; o[1][r] *= a; }
        }
        u32x4 pw[4];
        pw[0] = (u32x4){cvtpk(p0[0], p0[1]), cvtpk(p0[2], p0[3]), cvtpk(p0[4], p0[5]), cvtpk(p0[6], p0[7])};
        pw[1] = (u32x4){cvtpk(p0[8], p0[9]), cvtpk(p0[10], p0[11]), cvtpk(p0[12], p0[13]), cvtpk(p0[14], p0[15])};
        pw[2] = (u32x4){cvtpk(p1[0], p1[1]), cvtpk(p1[2], p1[3]), cvtpk(p1[4], p1[5]), cvtpk(p1[6], p1[7])};
        pw[3] = (u32x4){cvtpk(p1[8], p1[9]), cvtpk(p1[10], p1[11]), cvtpk(p1[12], p1[13]), cvtpk(p1[14], p1[15])};
        const LAS unsigned char* vp = lds + LDS_V + slot * VSLOT + vfo;
#pragma unroll
        for (int d0 = 0; d0 < 2; ++d0)
#pragma unroll
            for (int ks = 0; ks < 4; ++ks) {
                const s16x4 lo = __builtin_bit_cast(s16x4, __builtin_amdgcn_ds_read_tr16_b64_v4i16((LAS s16x4*)(vp + d0 * 4096 + ks * 1024)));
                const s16x4 hh = __builtin_bit_cast(s16x4, __builtin_amdgcn_ds_read_tr16_b64_v4i16((LAS s16x4*)(vp + d0 * 4096 + ks * 1024 + 512)));
                const bf16x8 vf = (bf16x8){lo[0], lo[1], lo[2], lo[3], hh[0], hh[1], hh[2], hh[3]};
                o[d0] = __builtin_amdgcn_mfma_f32_32x32x16_bf16(__builtin_bit_cast(bf16x8, pw[ks]), vf, o[d0], 0, 0, 0);
            }
    }
    l_run += __shfl_xor(l_run, 32);
    if (hi == 0) wsf[32 + r32] = l_run;
    asm volatile("s_waitcnt lgkmcnt(0)" ::: "memory");
    const int b = bh >> 3, h = bh & 7;
    bf16_t* Ow = concat + ((size_t)b * 2048 + qb * 256 + wid * 32) * 1024 + h * 64 + r32;
#pragma unroll
    for (int r = 0; r < 16; ++r) { const int q = crow(r, hi); const float rl = __builtin_amdgcn_rcpf(wsf[32 + q]);
        const unsigned w = cvtpk(o[0][r] * rl, o[1][r] * rl);
        Ow[(size_t)q * 1024] = (bf16_t)(w & 0xffffu); Ow[(size_t)q * 1024 + 32] = (bf16_t)(w >> 16); }
#undef ATT_DMA
}
}
__device__ __forceinline__ float wave_sum(float v) {
#pragma unroll
    for (int o = 1; o < 64; o <<= 1) v += __shfl_xor(v, o);
    return v;
}
__device__ __forceinline__ float bf2f(unsigned short b) { return __uint_as_float(((unsigned)b) << 16); }
__device__ __forceinline__ float bflo(unsigned w) { return __uint_as_float(w << 16); }
__device__ __forceinline__ float bfhi(unsigned w) { return __uint_as_float(w & 0xffff0000u); }
__device__ __forceinline__ unsigned pk2(float lo, float hi) { return pg8::cvt_pk_bf16(lo, hi); }
__device__ __forceinline__ float silu_fast(float v) { return v * __builtin_amdgcn_rcpf(1.0f + __builtin_amdgcn_exp2f(-1.4426950409f * v)); }
__device__ __forceinline__ float sigmoid_fast(float v) { return __builtin_amdgcn_rcpf(1.0f + __builtin_amdgcn_exp2f(-1.4426950409f * v)); }

__device__ __forceinline__ void transpose_item(const float* W, int ldw, int k0, int n0, bf16_t* WT, int ldt, int dst_row0, const float* kscale, LAS float* scr, int lane) {
#pragma unroll 8
    for (int i = 0; i < 32; ++i) { const int kk = 2 * i + (lane >> 5); float v = W[(size_t)(k0 + kk) * ldw + n0 + (lane & 31)]; if (kscale) v *= kscale[k0 + kk]; scr[kk * 33 + (lane & 31)] = v; }
    asm volatile("s_waitcnt lgkmcnt(0)" ::: "memory");
    const int c = lane & 7;
#pragma unroll
    for (int j = 0; j < 4; ++j) { const int n = (lane >> 3) + 8 * j; const LAS float* s = scr + (8 * c) * 33 + n;
        u32x4 o; o.x = pk2(s[0 * 33], s[1 * 33]); o.y = pk2(s[2 * 33], s[3 * 33]); o.z = pk2(s[4 * 33], s[5 * 33]); o.w = pk2(s[6 * 33], s[7 * 33]);
        *(u32x4*)(WT + (size_t)(dst_row0 + n) * ldt + k0 + 8 * c) = o; }
    asm volatile("s_waitcnt lgkmcnt(0)" ::: "memory");
}

__device__ __forceinline__ void norm_mod_row(const float* xr, const float* g, const float* shift, const float* scale, bf16_t* orow, int lane) {
    f32x4 v[4]; float ss = 0.f;
#pragma unroll
    for (int j = 0; j < 4; ++j) { v[j] = *(const f32x4*)(xr + 4 * lane + 256 * j); ss += (v[j].x * v[j].x + v[j].y * v[j].y) + (v[j].z * v[j].z + v[j].w * v[j].w); }
    const float rstd = 1.0f / sqrtf(wave_sum(ss) * (1.0f / 1024.0f) + 1e-6f);
#pragma unroll
    for (int j = 0; j < 4; ++j) { const int c = 4 * lane + 256 * j; const f32x4 gg = *(const f32x4*)(g + c), sc = *(const f32x4*)(scale + c), sh = *(const f32x4*)(shift + c);
        const f32x4 y = v[j] * rstd * gg * (sc + 1.0f) + sh; u32x2 o; o.x = pk2(y.x, y.y); o.y = pk2(y.z, y.w); *(u32x2*)(orow + c) = o; }
}
#define XB_TMO      128
#define XB_XCNT(j)  (256  + 64 * (j))
#define XB_XSUB(j)  (1280 + 64 * (j))
#define XB_XGEN(j)  (2304 + 64 * (j))
#define XB_TOP      3328
#define XB_TOPGEN   3392
#define XCD_BAR_WORDS 3456
#define XB_SPIN_CAP (1u << 18)
__device__ __forceinline__ unsigned xb_ld(unsigned* p)              { return __hip_atomic_load(p, __ATOMIC_RELAXED, __HIP_MEMORY_SCOPE_AGENT); }
__device__ __forceinline__ unsigned xb_add(unsigned* p, unsigned v) { return __hip_atomic_fetch_add(p, v, __ATOMIC_RELAXED, __HIP_MEMORY_SCOPE_AGENT); }
__device__ __forceinline__ unsigned xb_xcc_id() { return (unsigned)__builtin_amdgcn_s_getreg((3 << 11) | 20) & 0xFu; }
#define XB_SPIN(cond, bar) do { unsigned _sp = 0; while (cond) { __builtin_amdgcn_s_sleep(1); \
    if ((++_sp & 255u) == 0u) { if (xb_ld(&(bar)[XB_TMO])) break; if (_sp > XB_SPIN_CAP) { atomicAdd(&(bar)[XB_TMO], 1u); break; } } } } while (0)
struct XcdBarrier { unsigned* bar; unsigned x; volatile LAS unsigned* st; };
__device__ __forceinline__ XcdBarrier xcd_barrier_post(unsigned* bar, volatile LAS unsigned* st) {
    XcdBarrier b; b.bar = bar; b.x = xb_xcc_id(); b.st = st;
    if (threadIdx.x == 0) (void)xb_add(&bar[XB_XCNT(b.x)], 1u);
    return b;
}
__device__ __forceinline__ void xcd_barrier_complete(unsigned* bar, unsigned x, unsigned& nloc, unsigned& nx) {
    const unsigned G = gridDim.x * gridDim.y * gridDim.z;
    unsigned sum, cnt, mine, sp = 0u;
    for (;;) {
        sum = 0u; cnt = 0u; mine = 0u;
#pragma unroll
        for (unsigned j = 0; j < 16; ++j) { const unsigned c = xb_ld(&bar[XB_XCNT(j)]); sum += c; cnt += (c > 0u) ? 1u : 0u; mine = (j == x) ? c : mine; }
        if (sum == G) break;
        __builtin_amdgcn_s_sleep(1);
        if ((++sp & 255u) == 0u) { if (xb_ld(&bar[XB_TMO])) break; if (sp > XB_SPIN_CAP) { atomicAdd(&bar[XB_TMO], 1u); break; } }
    }
    nloc = mine > 0u ? mine : 1u; nx = cnt > 0u ? cnt : 1u;
}
__device__ __forceinline__ void xcd_barrier(const XcdBarrier& b) {
    asm volatile("s_waitcnt vmcnt(0)" ::: "memory");
    __syncthreads();
    if (threadIdx.x == 0) {
        unsigned* bar = b.bar;
        __builtin_amdgcn_s_waitcnt(0);
        unsigned nloc = b.st[0], nx = b.st[1];
        if (nloc == 0u) { xcd_barrier_complete(bar, b.x, nloc, nx); b.st[0] = nloc; b.st[1] = nx; }
        const unsigned old = xb_add(&bar[XB_XSUB(b.x)], 1u);
        const unsigned gen = old / nloc;
        if (old + 1u == (gen + 1u) * nloc) {
            __builtin_amdgcn_fence(__ATOMIC_RELEASE, "agent");
            asm volatile("s_waitcnt vmcnt(0)" ::: "memory");
            const unsigned og = xb_add(&bar[XB_TOP], 1u);
            const unsigned tg = og / nx;
            if (og + 1u == (tg + 1u) * nx) xb_add(&bar[XB_TOPGEN], 1u);
            else XB_SPIN(xb_ld(&bar[XB_TOPGEN]) == tg, bar);
            __builtin_amdgcn_fence(__ATOMIC_ACQUIRE, "agent");
            xb_add(&bar[XB_XGEN(b.x)], 1u);
            asm volatile("s_waitcnt vmcnt(0)" ::: "memory");
        } else {
            XB_SPIN(xb_ld(&bar[XB_XGEN(b.x)]) == gen, bar);
            __builtin_amdgcn_fence(__ATOMIC_ACQUIRE, "agent");
            asm volatile("s_waitcnt vmcnt(0)" ::: "memory");
        }
    }
    __syncthreads();
}

struct Args { const float* in[34]; float* out; unsigned char* ws; int ph_lo, ph_hi; };
static_assert(sizeof(Args) == 36 * 8 + 8, "Args has no padding");

#ifndef PHASE_MASK
#define PHASE_MASK 0x7ffff
#endif
#define IN(k) (((PHASE_MASK >> (k)) & 1) && lo <= (k) && (k) < hi)
#define SEAM(k) do { if (IN(k) && IN((k) + 1)) xcd_barrier(bar); } while (0)
#define DECL_LOCALS \
    const int tid = threadIdx.x, lane = tid & 63, wid = __builtin_amdgcn_readfirstlane(tid >> 6); \
    const int G = gridDim.x, bx = blockIdx.x; \
    const int gw = bx * 8 + wid, NGW = G * 8; \
    const int lo = a.ph_lo, hi = a.ph_hi; \
    unsigned char* ws = a.ws; \
    unsigned* ctl = (unsigned*)(ws + OFF_CTL); \
    const float* x = a.in[0]; const float* cvec = a.in[1]; const float* ctx = a.in[2]; const float* cctx = a.in[3]; \
    const float* w_ada = a.in[4]; const float* b_ada = a.in[5]; const float* n1g = a.in[6]; const float* n2g = a.in[7]; \
    const float* a_w_in = a.in[8]; const float* a_qng = a.in[9]; const float* a_w_uq = a.in[10]; const float* a_kvng = a.in[11]; \
    const float* a_w_ukv = a.in[12]; const float* a_qg = a.in[13]; const float* a_kg = a.in[14]; \
    const float* b_w_dw = a.in[15]; const float* b_b_dw = a.in[16]; const float* b_ln_g = a.in[17]; const float* b_ln_b = a.in[18]; \
    const float* ab_w_out = a.in[19]; const float* c_w_in = a.in[20]; const float* c_b_in = a.in[21]; const float* c_ln_g = a.in[22]; \
    const float* c_ln_b = a.in[23]; const float* c_w_s = a.in[24]; const float* c_b_s = a.in[25]; const float* c_w_out = a.in[26]; \
    const float* m_wg = a.in[27]; const float* m_bg = a.in[28]; const float* m_wr = a.in[29]; const float* m_br = a.in[30]; \
    const float* m_gate = a.in[31]; const float* m_up = a.in[32]; const float* m_down = a.in[33]; \
    float* xres = a.out; \
    float* mod = (float*)(ws + OFF_MOD); float* ropec = (float*)(ws + OFF_ROPE); float* ropes = ropec + 2048 * 16; \
    bf16_t* rfrag = (bf16_t*)(ws + OFF_RFRAG); float* rbias = (float*)(ws + OFF_RBIAS); \
    bf16_t* WIN_T = (bf16_t*)(ws + OFF_WIN); bf16_t* WUQ_T = (bf16_t*)(ws + OFF_WUQ); bf16_t* WUKV_T = (bf16_t*)(ws + OFF_WUKV); bf16_t* WOUT_T = (bf16_t*)(ws + OFF_WOUT); \
    bf16_t* CIN_T = (bf16_t*)(ws + OFF_CIN); bf16_t* COUT_T = (bf16_t*)(ws + OFF_COUT); bf16_t* WSB = (bf16_t*)(ws + OFF_WSB); \
    bf16_t* MGU_T = (bf16_t*)(ws + OFF_MGU); bf16_t* MDN_T = (bf16_t*)(ws + OFF_MDN); \
    int* list = (int*)(ws + OFF_LIST); float* listw = (float*)(ws + OFF_LISTW); int* tokslot = (int*)(ws + OFF_TOKSLOT); \
    bf16_t* hb = (bf16_t*)(ws + OFF_HB); bf16_t* proj = (bf16_t*)(ws + OFF_PROJ); bf16_t* qn = (bf16_t*)(ws + OFF_QN); bf16_t* kvn = (bf16_t*)(ws + OFF_KVN); bf16_t* zb = (bf16_t*)(ws + OFF_Z); \
    bf16_t* qraw = (bf16_t*)(ws + OFF_QRAW); bf16_t* kvraw = (bf16_t*)(ws + OFF_KVRAW); bf16_t* Qb = (bf16_t*)(ws + OFF_Q); bf16_t* Kb = (bf16_t*)(ws + OFF_K); bf16_t* Vb = (bf16_t*)(ws + OFF_V); \
    bf16_t* concat = (bf16_t*)(ws + OFF_CONCAT); float* krb = (float*)(ws + OFF_KR); \
    bf16_t* h2 = (bf16_t*)(ws + OFF_H2); bf16_t* actb = (bf16_t*)(ws + OFF_ACT); bf16_t* heb = (bf16_t*)(ws + OFF_HE); bf16_t* zz = (bf16_t*)(ws + OFF_ZZ); \
    (void)0;

template <int l> __device__ __forceinline__ void layer_tail(const Args& a, LAS unsigned char* lds, const XcdBarrier& bar) {
    using namespace cfg;
    DECL_LOCALS
        if (l == 1) {
            if (IN(12)) {
                pg8::Gemm g{hb, CIN_T, 1024, 1024, 1024, 0}; pg8::StaticOrder S; S.init(T, 4096, G, bx);
                pg8::EpiBf16<1> E{zz, 4096, c_b_in};
                pg8::gemm_phase<pg8::EpiBf16<1>, pg8::StaticOrder, false>(lds, g, S, E, nullptr);
            }
            SEAM(12);
            if (IN(13)) {
                LAS unsigned char* VT = lds; LAS f32x2* stat = (LAS f32x2*)(lds + 69632);
                const int g4 = lane >> 4, qq = (lane & 15) >> 2, p4 = lane & 3;
                for (int n = bx; n < 256; n += G) {
                    const size_t R0 = (size_t)n * 128;
                    for (int rr = 0; rr < 16; ++rr) { const int row = wid * 16 + rr; const bf16_t* vp = zz + (R0 + row) * 4096 + 2048 + 8 * lane;
                        float v[32];
#pragma unroll
                        for (int j = 0; j < 4; ++j) { const u32x4 w = *(const u32x4*)(vp + 512 * j);
#pragma unroll
                            for (int e = 0; e < 4; ++e) { v[8 * j + 2 * e] = bflo(w[e]); v[8 * j + 2 * e + 1] = bfhi(w[e]); } }
                        float s = 0.f;
#pragma unroll
                        for (int e = 0; e < 32; ++e) s += v[e];
                        const float mean = wave_sum(s) * (1.0f / 2048.0f); float q = 0.f;
#pragma unroll
                        for (int e = 0; e < 32; ++e) { const float d = v[e] - mean; q += d * d; }
                        const float rstd = 1.0f / sqrtf(wave_sum(q) * (1.0f / 2048.0f) + 1e-5f);
                        if (lane == 0) stat[row] = (f32x2){mean, rstd}; }
                    __syncthreads();
                    for (int g = 0; g < 8; ++g) {
                        { const int cc = tid & 31, q0 = tid >> 5;
                          const f32x4 lg0 = *(const f32x4*)(c_ln_g + 256 * g + 8 * cc), lg1 = *(const f32x4*)(c_ln_g + 256 * g + 8 * cc + 4), lb0 = *(const f32x4*)(c_ln_b + 256 * g + 8 * cc), lb1 = *(const f32x4*)(c_ln_b + 256 * g + 8 * cc + 4);
#pragma unroll
                          for (int j = 0; j < 8; ++j) { const int q = q0 + 16 * j; const u32x4 w = *(const u32x4*)(zz + (R0 + q) * 4096 + 2048 + 256 * g + 8 * cc); const f32x2 st = stat[q];
                              const f32x4 a0 = ((f32x4){bflo(w.x), bfhi(w.x), bflo(w.y), bfhi(w.y)} - st.x) * st.y * lg0 + lb0, a1 = ((f32x4){bflo(w.z), bfhi(w.z), bflo(w.w), bfhi(w.w)} - st.x) * st.y * lg1 + lb1;
                              *(LAS u32x4*)(VT + q * 544 + cc * 16) = (u32x4){pk2(a0.x, a0.y), pk2(a0.z, a0.w), pk2(a1.x, a1.y), pk2(a1.z, a1.w)}; } }
                        __syncthreads();
                        f32x4 acc[2][8];
#pragma unroll
                        for (int mb = 0; mb < 2; ++mb)
#pragma unroll
                            for (int nb = 0; nb < 8; ++nb) acc[mb][nb] = (f32x4){0.f, 0.f, 0.f, 0.f};
#pragma unroll
                        for (int kb = 0; kb < 4; ++kb) {
                            bf16x8 af[2];
#pragma unroll
                            for (int mb = 0; mb < 2; ++mb) { const LAS unsigned char* ap = VT + (32 * kb + 8 * g4 + qq) * 544 + (32 * wid + 16 * mb) * 2 + 8 * p4;
                                const att::s16x4 t0 = __builtin_bit_cast(att::s16x4, __builtin_amdgcn_ds_read_tr16_b64_v4i16((LAS att::s16x4*)(ap)));
                                const att::s16x4 t1 = __builtin_bit_cast(att::s16x4, __builtin_amdgcn_ds_read_tr16_b64_v4i16((LAS att::s16x4*)(ap + 4 * 544)));
                                af[mb] = (bf16x8){t0[0], t0[1], t0[2], t0[3], t1[0], t1[1], t1[2], t1[3]}; }
#pragma unroll
                            for (int nb = 0; nb < 8; ++nb) { const bf16x8 bfr = *(const bf16x8*)(WSB + ((size_t)(g * 128 + 16 * nb + (lane & 15))) * 128 + 32 * kb + 8 * g4);
#pragma unroll
                                for (int mb = 0; mb < 2; ++mb) acc[mb][nb] = __builtin_amdgcn_mfma_f32_16x16x32_bf16(af[mb], bfr, acc[mb][nb], 0, 0, 0); }
                        }
#pragma unroll
                        for (int nb = 0; nb < 8; ++nb) { const int p = 16 * nb + (lane & 15); const float bs = c_b_s[g * 128 + p];
#pragma unroll
                            for (int mb = 0; mb < 2; ++mb) { bf16_t* up = zz + (R0 + p) * 4096 + 256 * g + 32 * wid + 16 * mb + 4 * g4; const u32x2 uw = *(const u32x2*)up;
                                u32x2 o; o.x = pk2(bflo(uw.x) * (acc[mb][nb][0] + bs), bfhi(uw.x) * (acc[mb][nb][1] + bs)); o.y = pk2(bflo(uw.y) * (acc[mb][nb][2] + bs), bfhi(uw.y) * (acc[mb][nb][3] + bs));
                                *(u32x2*)up = o; } }
                        __syncthreads();
                    }
                }
            }
            SEAM(13);
            if (IN(14)) {
                pg8::Gemm g{zz, COUT_T, 4096, 2048, 2048, 0}; pg8::StaticOrder S; S.init(T, 1024, G, bx);
                pg8::EpiResid E{xres, xres, mod + (size_t)17 * 6144 + 2048, 6144};
                pg8::gemm_phase<pg8::EpiResid, pg8::StaticOrder, false>(lds, g, S, E, nullptr);
            }
            SEAM(14);
        }
        const int pb = l ? 15 : 8;
        const float* modl = mod + (size_t)l * 17 * 6144;
        unsigned* gcnt = ctl + CW_GCNT + l * 32 * 64;
        LAS int* tb = (LAS int*)(lds + LDS_TB); LAS int* cntl = (LAS int*)(lds + LDS_CNT);
        if (IN(pb)) {
            LAS float* lg = (LAS float*)lds + wid * 768;
            LAS int* hist = (LAS int*)(lds + 32768); LAS int* hist2 = hist + 32; LAS int* basel = hist + 64; LAS int* re = hist + 128; LAS float* rw = (LAS float*)(hist + 128 + 256);
            const float* gn = n2g + l * 1024; const bf16_t* rf = rfrag + (size_t)l * 32 * 3 * 2 * 512;
            const int r16 = lane & 15, kg = lane >> 4;
            for (int blk = bx; blk < 256; blk += G) {
                if (tid < 64) hist[tid] = 0;
                const int t0 = blk * 128 + wid * 16, tok = t0 + r16; const float* md = modl + (size_t)(t0 >> 11) * 6144;
                const float* xr = xres + (size_t)tok * 1024 + 8 * kg;
                float ss = 0.f;
                for (int kb = 0; kb < 32; ++kb) { const f32x4 v0 = *(const f32x4*)(xr + 32 * kb), v1 = *(const f32x4*)(xr + 32 * kb + 4);
                    ss += (v0.x * v0.x + v0.y * v0.y) + (v0.z * v0.z + v0.w * v0.w) + (v1.x * v1.x + v1.y * v1.y) + (v1.z * v1.z + v1.w * v1.w); }
                ss += __shfl_xor(ss, 16); ss += __shfl_xor(ss, 32);
                const float rstd = 1.0f / sqrtf(ss * (1.0f / 1024.0f) + 1e-6f);
                f32x4 acc[3];
#pragma unroll
                for (int cb = 0; cb < 3; ++cb) acc[cb] = (f32x4){0.f, 0.f, 0.f, 0.f};
                for (int kb = 0; kb < 32; ++kb) { const int c = 32 * kb + 8 * kg;
                    const f32x4 v0 = *(const f32x4*)(xr + 32 * kb), v1 = *(const f32x4*)(xr + 32 * kb + 4);
                    const f32x4 y0 = v0 * rstd * *(const f32x4*)(gn + c) * (*(const f32x4*)(md + 4096 + c) + 1.0f) + *(const f32x4*)(md + 3072 + c);
                    const f32x4 y1 = v1 * rstd * *(const f32x4*)(gn + c + 4) * (*(const f32x4*)(md + 4096 + c + 4) + 1.0f) + *(const f32x4*)(md + 3072 + c + 4);
                    const u32x4 hw = (u32x4){pk2(y0.x, y0.y), pk2(y0.z, y0.w), pk2(y1.x, y1.y), pk2(y1.z, y1.w)};
                    *(u32x4*)(h2 + (size_t)tok * 1024 + c) = hw;
                    const u32x4 lw = (u32x4){pk2(y0.x - bflo(hw.x), y0.y - bfhi(hw.x)), pk2(y0.z - bflo(hw.y), y0.w - bfhi(hw.y)), pk2(y1.x - bflo(hw.z), y1.y - bfhi(hw.z)), pk2(y1.z - bflo(hw.w), y1.w - bfhi(hw.w))};
                    const bf16x8 Hh = __builtin_bit_cast(bf16x8, hw), Hl = __builtin_bit_cast(bf16x8, lw);
#pragma unroll
                    for (int cb = 0; cb < 3; ++cb) { const bf16x8 Wh = *(const bf16x8*)(rf + ((size_t)((kb * 3 + cb) * 2 + 0) * 64 + lane) * 8), Wl = *(const bf16x8*)(rf + ((size_t)((kb * 3 + cb) * 2 + 1) * 64 + lane) * 8);
                        acc[cb] = __builtin_amdgcn_mfma_f32_16x16x32_bf16(Wh, Hh, acc[cb], 0, 0, 0);
                        acc[cb] = __builtin_amdgcn_mfma_f32_16x16x32_bf16(Wh, Hl, acc[cb], 0, 0, 0);
                        acc[cb] = __builtin_amdgcn_mfma_f32_16x16x32_bf16(Wl, Hh, acc[cb], 0, 0, 0); }
                }
#pragma unroll
                for (int cb = 0; cb < 3; ++cb)
#pragma unroll
                    for (int e = 0; e < 4; ++e) lg[r16 * 48 + 16 * cb + 4 * kg + e] = acc[cb][e] + rbias[l * 48 + 16 * cb + 4 * kg + e];
                __syncthreads();
                int e0 = 0, e1 = 0; float w0 = 0.f, w1 = 0.f;
                if (lane < 16) {
                    const LAS float* L = lg + lane * 48;
                    int gi = 0; float gm = L[32];
#pragma unroll
                    for (int g = 1; g < 4; ++g) { const float v = L[32 + g]; if (v > gm) { gm = v; gi = g; } }
                    float gs = 0.f;
#pragma unroll
                    for (int g = 0; g < 4; ++g) gs += expf(L[32 + g] - gm);
                    const float gwt = 1.0f / gs;
                    float v0 = -1e30f, v1 = -1e30f; int i0 = 0, i1 = 0;
#pragma unroll
                    for (int e = 0; e < 8; ++e) { const float v = L[gi * 8 + e]; if (v > v0) { v1 = v0; i1 = i0; v0 = v; i0 = e; } else if (v > v1) { v1 = v; i1 = e; } }
                    const float ex = expf(v1 - v0); w0 = gwt / (1.0f + ex); w1 = gwt * ex / (1.0f + ex);
                    e0 = gi * 8 + i0; e1 = gi * 8 + i1;
                    __hip_atomic_fetch_add(&hist[e0], 1, __ATOMIC_RELAXED, __HIP_MEMORY_SCOPE_WORKGROUP); __hip_atomic_fetch_add(&hist[e1], 1, __ATOMIC_RELAXED, __HIP_MEMORY_SCOPE_WORKGROUP);
                }
                __syncthreads();
                if (tid < 32) basel[tid] = (int)atomicAdd(gcnt + tid * 64, (unsigned)hist[tid]);
                __syncthreads();
                if (lane < 16) {
                    const int p0 = basel[e0] + __hip_atomic_fetch_add(&hist2[e0], 1, __ATOMIC_RELAXED, __HIP_MEMORY_SCOPE_WORKGROUP), p1 = basel[e1] + __hip_atomic_fetch_add(&hist2[e1], 1, __ATOMIC_RELAXED, __HIP_MEMORY_SCOPE_WORKGROUP);
                    list[e0 * 32768 + p0] = tok; listw[e0 * 32768 + p0] = w0; list[e1 * 32768 + p1] = tok; listw[e1 * 32768 + p1] = w1;
                    tokslot[tok * 2] = e0 * 32768 + p0; tokslot[tok * 2 + 1] = e1 * 32768 + p1;
                }
                __syncthreads();
            }
        }
        SEAM(pb);
        if (IN(pb + 1) || IN(pb + 2) || IN(pb + 3)) {
            __syncthreads();
            if (tid == 0) { int accn = 0; for (int e = 0; e < 32; ++e) { const int c = (int)__hip_atomic_load(gcnt + e * 64, __ATOMIC_RELAXED, __HIP_MEMORY_SCOPE_AGENT); cntl[e] = c; tb[e] = accn; accn += (c + 255) >> 8; } tb[32] = accn; }
            __syncthreads();
        }
        if (IN(pb + 1)) {
            LAS int* tokl = (LAS int*)(lds + LDS_TOKL); LAS float* wl = (LAS float*)(lds + LDS_WL);
            volatile LAS int* ut = (volatile LAS int*)(lds + LDS_UT);
            if (tid == 0) pg8::build_units(ut, tb, 2, G, bx);
            __syncthreads();
            pg8::GroupedOrder S{ut, __builtin_amdgcn_readfirstlane(ut[32])};
            { pg8::Unit u; for (int ui = 0; ui < 4 && S.next(ui, u); ++ui) if (tid < 256) { const int pos = u.aux * 256 + tid; const bool ok = pos < cntl[u.eb];
                  tokl[ui * 256 + tid] = ok ? list[u.eb * 32768 + pos] : 0; wl[ui * 256 + tid] = ok ? listw[u.eb * 32768 + pos] : 0.f; } }
            __syncthreads();
            pg8::Gemm g{h2, MGU_T + (size_t)l * 32 * 512 * 1024, 1024, 1024, 1024, (size_t)512 * 1024};
            pg8::EpiAct E{actb, wl};
            pg8::gemm_phase<pg8::EpiAct, pg8::GroupedOrder, true>(lds, g, S, E, tokl);
        }
        SEAM(pb + 1);
        if (IN(pb + 2)) {
            volatile LAS int* ut = (volatile LAS int*)(lds + LDS_UT);
            if (tid == 0) pg8::build_units(ut, tb, 4, G, bx);
            __syncthreads();
            pg8::GroupedOrder S{ut, __builtin_amdgcn_readfirstlane(ut[32])};
            pg8::Gemm g{actb, MDN_T + (size_t)l * 32 * 1024 * 256, 256, 256, 256, (size_t)1024 * 256};
            pg8::EpiBf16<0> E{heb, 1024, nullptr};
            pg8::gemm_phase<pg8::EpiBf16<0>, pg8::GroupedOrder, false>(lds, g, S, E, nullptr);
        }
        SEAM(pb + 2);
        if (IN(pb + 3)) {
            for (int tok = gw; tok < T; tok += NGW) {
                const int s0 = tokslot[tok * 2], s1 = tokslot[tok * 2 + 1];
                const size_t r0 = (size_t)tb[s0 >> 15] * 256 + (s0 & 32767), r1 = (size_t)tb[s1 >> 15] * 256 + (s1 & 32767);
                const int b = tok >> 11; const float* g2 = modl + (size_t)b * 6144 + 5120;
                f32x4 y[4]; float ss = 0.f;
#pragma unroll
                for (int j = 0; j < 4; ++j) { const int c = 4 * lane + 256 * j; const f32x4 xv = *(const f32x4*)(xres + (size_t)tok * 1024 + c);
                    const u32x2 h0 = *(const u32x2*)(heb + r0 * 1024 + c), h1 = *(const u32x2*)(heb + r1 * 1024 + c);
                    const f32x4 m = (f32x4){bflo(h0.x) + bflo(h1.x), bfhi(h0.x) + bfhi(h1.x), bflo(h0.y) + bflo(h1.y), bfhi(h0.y) + bfhi(h1.y)};
                    y[j] = xv + *(const f32x4*)(g2 + c) * m; *(f32x4*)(xres + (size_t)tok * 1024 + c) = y[j];
                    ss += (y[j].x * y[j].x + y[j].y * y[j].y) + (y[j].z * y[j].z + y[j].w * y[j].w); }
                if (l == 0) {
                    const float rstd = 1.0f / sqrtf(wave_sum(ss) * (1.0f / 1024.0f) + 1e-6f);
                    const float* m1 = mod + (size_t)(17 + b) * 6144;
#pragma unroll
                    for (int j = 0; j < 4; ++j) { const int c = 4 * lane + 256 * j;
                        const f32x4 o = y[j] * rstd * *(const f32x4*)(n1g + 1024 + c) * (*(const f32x4*)(m1 + 1024 + c) + 1.0f) + *(const f32x4*)(m1 + c);
                        u32x2 ow; ow.x = pk2(o.x, o.y); ow.y = pk2(o.z, o.w); *(u32x2*)(hb + (size_t)tok * 1024 + c) = ow; }
                }
            }
        }
        if (l == 0) SEAM(11);
}

__global__ void __launch_bounds__(512, 2) fwd(Args a) {
    using namespace cfg;
    extern __shared__ __attribute__((aligned(16))) unsigned char lds_raw[];
    LAS unsigned char* lds = (LAS unsigned char*)lds_raw;
    DECL_LOCALS
    volatile LAS unsigned* MISC = (volatile LAS unsigned*)(lds + LDS_MISC);
    if (tid < 16) MISC[tid] = 0u;
    __syncthreads();
    XcdBarrier bar; bar.bar = ctl + CW_BAR; bar.x = 0; bar.st = nullptr;
    const bool multi = (hi - lo) > 1;
    if (multi) bar = xcd_barrier_post(ctl + CW_BAR, MISC + 8);

    if (IN(0)) {
        if (bx < 192) {
            const int l = bx / 96, jb = bx % 96;
            LAS float* sl = (LAS float*)lds; LAS float* part = (LAS float*)(lds + 69632);
            for (int i = tid; i < 17 * 1024; i += 512) { const int r = i >> 10, k = i & 1023; const float v = (r < 16) ? cvec[r * 1024 + k] : cctx[k]; sl[i] = v / (1.0f + expf(-v)); }
            __syncthreads();
            float acc[17];
#pragma unroll
            for (int r = 0; r < 17; ++r) acc[r] = 0.f;
            const float* wp = w_ada + (size_t)l * 1024 * 6144 + jb * 64 + lane;
            for (int k = wid * 128; k < wid * 128 + 128; ++k) { const float w = wp[(size_t)k * 6144];
#pragma unroll
                for (int r = 0; r < 17; ++r) acc[r] += sl[r * 1024 + k] * w; }
#pragma unroll
            for (int r = 0; r < 17; ++r) part[(wid * 17 + r) * 64 + lane] = acc[r];
            __syncthreads();
            for (int i = tid; i < 17 * 64; i += 512) { const int r = i >> 6, j = i & 63; float s = 0.f;
#pragma unroll
                for (int q = 0; q < 8; ++q) s += part[(q * 17 + r) * 64 + j];
                mod[((size_t)l * 17 + r) * 6144 + jb * 64 + j] = s + b_ada[l * 6144 + jb * 64 + j]; }
            __syncthreads();
        }
        {
            LAS float* scr = (LAS float*)(lds + wid * 16384);
            constexpr int I_WIN = 16 * 53, I_UQ = 6 * 24, I_UKV = 4 * 32, I_OUT = 16 * 32, I_CIN = 16 * 128, I_COUT = 32 * 32, I_MOE = 64 * 384;
            constexpr int NITEMS = I_WIN + I_UQ + I_UKV + I_OUT + I_CIN + I_COUT + I_MOE;
            for (int it = gw; it < NITEMS; it += NGW) {
                int r = it;
                if (r < I_WIN) { transpose_item(a_w_in, 1696, 64 * (r / 53), 32 * (r % 53), WIN_T, 1024, 32 * (r % 53), nullptr, scr, lane); continue; } r -= I_WIN;
                if (r < I_UQ) { transpose_item(a_w_uq, 768, 64 * (r / 24), 32 * (r % 24), WUQ_T, 384, 32 * (r % 24), a_qng, scr, lane); continue; } r -= I_UQ;
                if (r < I_UKV) { transpose_item(a_w_ukv, 1024, 64 * (r / 32), 32 * (r % 32), WUKV_T, 256, 32 * (r % 32), a_kvng, scr, lane); continue; } r -= I_UKV;
                if (r < I_OUT) { transpose_item(ab_w_out, 1024, 64 * (r / 32), 32 * (r % 32), WOUT_T, 1024, 32 * (r % 32), nullptr, scr, lane); continue; } r -= I_OUT;
                if (r < I_CIN) { transpose_item(c_w_in, 4096, 64 * (r / 128), 32 * (r % 128), CIN_T, 1024, 32 * (r % 128), nullptr, scr, lane); continue; } r -= I_CIN;
                if (r < I_COUT) { transpose_item(c_w_out, 1024, 64 * (r / 32), 32 * (r % 32), COUT_T, 2048, 32 * (r % 32), nullptr, scr, lane); continue; } r -= I_COUT;
                const int le = r / 384, q = r % 384;
                if (q < 128) { const int n0 = 32 * (q % 8); transpose_item(m_gate + (size_t)le * 1024 * 256, 256, 64 * (q / 8), n0, MGU_T + (size_t)le * 512 * 1024, 1024, (n0 >> 7) * 256 + (n0 & 127), nullptr, scr, lane); }
                else if (q < 256) { const int q2 = q - 128, n0 = 32 * (q2 % 8); transpose_item(m_up + (size_t)le * 1024 * 256, 256, 64 * (q2 / 8), n0, MGU_T + (size_t)le * 512 * 1024, 1024, (n0 >> 7) * 256 + 128 + (n0 & 127), nullptr, scr, lane); }
                else { const int q2 = q - 256; transpose_item(m_down + (size_t)le * 256 * 1024, 1024, 64 * (q2 / 32), 32 * (q2 % 32), MDN_T + (size_t)le * 1024 * 256, 256, 32 * (q2 % 32), nullptr, scr, lane); }
            }
        }
        {
            const int gt = bx * 512 + tid, NGT = G * 512;
            for (int i = gt; i < 96 * 128; i += NGT) *(u32x4*)(WIN_T + (size_t)1696 * 1024 + (size_t)i * 8) = (u32x4){0u, 0u, 0u, 0u};
            for (int i = gt; i < 8 * 128 * 128 / 8; i += NGT) { const f32x4 v0 = *(const f32x4*)(c_w_s + (size_t)i * 8), v1 = *(const f32x4*)(c_w_s + (size_t)i * 8 + 4);
                *(u32x4*)(WSB + (size_t)i * 8) = (u32x4){pk2(v0.x, v0.y), pk2(v0.z, v0.w), pk2(v1.x, v1.y), pk2(v1.z, v1.w)}; }
            for (int i = gt; i < 2048 * 16; i += NGT) { const int pos = i >> 4, j = i & 15; const float p = (j < 8) ? (float)(pos >> 6) : (float)(pos & 63);
                const float ang = p * powf(10000.f, -(float)(j & 7) / 8.f); ropec[i] = cosf(ang); ropes[i] = sinf(ang); }
            for (int i = gt; i < 2 * 32 * 3 * 2 * 64; i += NGT) {
                const int ln = i & 63, hl = (i >> 6) & 1, rest = i >> 7, cb = rest % 3, kb = (rest / 3) % 32, l = rest / 96;
                const int o = 16 * cb + (ln & 15), d0 = 32 * kb + 8 * (ln >> 4); unsigned w[4];
#pragma unroll
                for (int jj = 0; jj < 4; ++jj) { float v[2];
#pragma unroll
                    for (int e = 0; e < 2; ++e) { const int d = d0 + 2 * jj + e; float f = 0.f;
                        if (o < 32) f = m_wr[(((size_t)l * 4 + (o >> 3)) * 1024 + d) * 8 + (o & 7)]; else if (o < 36) f = m_wg[((size_t)l * 1024 + d) * 4 + (o - 32)];
                        const float fh = __uint_as_float(pk2(f, 0.f) << 16); v[e] = hl ? (f - fh) : f; }
                    w[jj] = pk2(v[0], v[1]); }
                *(u32x4*)(rfrag + (size_t)i * 8) = (u32x4){w[0], w[1], w[2], w[3]}; }
            for (int i = gt; i < 2 * 48; i += NGT) { const int l = i / 48, o = i % 48; rbias[i] = (o < 32) ? m_br[l * 32 + o] : (o < 36 ? m_bg[l * 4 + o - 32] : 0.f); }
        }
    }
    SEAM(0);
    if (IN(1)) {
        for (int row = gw; row < TA; row += NGW) {
            const float* src; const float* md;
            if (row < T) { src = x + (size_t)row * 1024; md = mod + (size_t)(row >> 11) * 6144; } else { src = ctx + (size_t)(row - T) * 1024; md = mod + (size_t)16 * 6144; }
            norm_mod_row(src, n1g, md, md + 1024, hb + (size_t)row * 1024, lane);
        }
    }
    SEAM(1);
    if (IN(2)) {
        pg8::Gemm g{hb, WIN_T, 1024, 1024, 1024, 0}; pg8::StaticOrder S; S.init(TA, AINP, G, bx);
        pg8::EpiBf16<0> E{proj, AINP, nullptr};
        pg8::gemm_phase<pg8::EpiBf16<0>, pg8::StaticOrder, false>(lds, g, S, E, nullptr);
    }
    SEAM(2);
    if (IN(3)) {
        for (int row = gw; row < TA; row += NGW) {
            const bf16_t* pr = proj + (size_t)row * AINP;
            { const u32x2 w = *(const u32x2*)(pr + 384 + 4 * lane); const float v0 = bflo(w.x), v1 = bfhi(w.x), v2 = bflo(w.y), v3 = bfhi(w.y);
              const float rstd = 1.0f / sqrtf(wave_sum((v0 * v0 + v1 * v1) + (v2 * v2 + v3 * v3)) * (1.0f / 256.0f) + 1e-6f);
              u32x2 o; o.x = pk2(v0 * rstd, v1 * rstd); o.y = pk2(v2 * rstd, v3 * rstd); *(u32x2*)(kvn + (size_t)row * 256 + 4 * lane) = o; }
            if (lane < 32) krb[(size_t)row * 32 + lane] = bf2f(pr[640 + lane]);
            if (row < T) {
                const unsigned* pq = (const unsigned*)(pr + 6 * lane); const unsigned w0 = pq[0], w1 = pq[1], w2 = pq[2];
                const float q0 = bflo(w0), q1 = bfhi(w0), q2 = bflo(w1), q3 = bfhi(w1), q4 = bflo(w2), q5 = bfhi(w2);
                const float rstd = 1.0f / sqrtf(wave_sum((q0 * q0 + q1 * q1) + (q2 * q2 + q3 * q3) + (q4 * q4 + q5 * q5)) * (1.0f / 384.0f) + 1e-6f);
                unsigned* oq = (unsigned*)(qn + (size_t)row * 384 + 6 * lane); oq[0] = pk2(q0 * rstd, q1 * rstd); oq[1] = pk2(q2 * rstd, q3 * rstd); oq[2] = pk2(q4 * rstd, q5 * rstd);
                const u32x4 av = *(const u32x4*)(pr + 672 + 8 * lane), bv = *(const u32x4*)(pr + 1184 + 8 * lane); u32x4 zo;
#pragma unroll
                for (int j = 0; j < 4; ++j) zo[j] = pk2(bflo(av[j]) * sigmoid_fast(bflo(bv[j])), bfhi(av[j]) * sigmoid_fast(bfhi(bv[j])));
                *(u32x4*)(zb + (size_t)row * 512 + 8 * lane) = zo;
            }
        }
    }
    SEAM(3);
    if (IN(4)) {
        { pg8::Gemm g{qn, WUQ_T, 384, 384, 384, 0}; pg8::StaticOrder S; S.init(T, 768, G, bx); pg8::EpiBf16<0> E{qraw, 768, nullptr};
          pg8::gemm_phase<pg8::EpiBf16<0>, pg8::StaticOrder, false>(lds, g, S, E, nullptr); }
        { pg8::Gemm g{kvn, WUKV_T, 256, 256, 256, 0}; pg8::StaticOrder S; S.init(TA, 1024, G, bx); pg8::EpiBf16<0> E{kvraw, 1024, nullptr};
          pg8::gemm_phase<pg8::EpiBf16<0>, pg8::StaticOrder, false>(lds, g, S, E, nullptr); }
        __syncthreads();
        LAS unsigned char* zin = lds; LAS float* cvo = (LAS float*)(lds + 63488);
        float wd[31];
#pragma unroll
        for (int w = 0; w < 31; ++w) wd[w] = b_w_dw[w * 512 + tid];
        const float cbias = b_b_dw[tid];
        for (int u = bx; u < 1024; u += G) {
            const int b = u >> 6, t0 = (u & 63) * 32;
            for (int idx = tid; idx < 62 * 64; idx += 512) { const int i = idx >> 6, c16 = idx & 63, tt = t0 - 15 + i;
                u32x4 v = (u32x4){0u, 0u, 0u, 0u}; if (tt >= 0 && tt < 2048) v = *(const u32x4*)(zb + ((size_t)(b * 2048 + tt)) * 512 + c16 * 8);
                *(LAS u32x4*)(zin + i * 1024 + c16 * 16) = v; }
            __syncthreads();
            float acc[32];
#pragma unroll
            for (int t = 0; t < 32; ++t) acc[t] = 0.f;
#pragma unroll
            for (int i = 0; i < 62; ++i) { const float zi = bf2f(*(const LAS unsigned short*)(zin + i * 1024 + tid * 2));
#pragma unroll
                for (int t = 0; t < 32; ++t) if (i - t >= 0 && i - t <= 30) acc[t] += zi * wd[i - t]; }
#pragma unroll
            for (int t = 0; t < 32; ++t) cvo[t * 512 + tid] = acc[t] + cbias;
            __syncthreads();
#pragma unroll
            for (int k = 0; k < 4; ++k) { const int t = wid * 4 + k; const f32x4 v0 = *(const LAS f32x4*)(cvo + t * 512 + 8 * lane), v1 = *(const LAS f32x4*)(cvo + t * 512 + 8 * lane + 4);
                const float mean = wave_sum((v0.x + v0.y) + (v0.z + v0.w) + (v1.x + v1.y) + (v1.z + v1.w)) * (1.0f / 512.0f);
                const f32x4 d0 = v0 - mean, d1 = v1 - mean;
                const float var = wave_sum((d0.x * d0.x + d0.y * d0.y) + (d0.z * d0.z + d0.w * d0.w) + (d1.x * d1.x + d1.y * d1.y) + (d1.z * d1.z + d1.w * d1.w)) * (1.0f / 512.0f);
                const float rstd = 1.0f / sqrtf(var + 1e-5f);
                const f32x4 g0 = *(const f32x4*)(b_ln_g + 8 * lane), g1 = *(const f32x4*)(b_ln_g + 8 * lane + 4), e0 = *(const f32x4*)(b_ln_b + 8 * lane), e1 = *(const f32x4*)(b_ln_b + 8 * lane + 4);
                const f32x4 y0 = d0 * rstd * g0 + e0, y1 = d1 * rstd * g1 + e1;
                u32x4 o; o.x = pk2(silu_fast(y0.x), silu_fast(y0.y)); o.y = pk2(silu_fast(y0.z), silu_fast(y0.w)); o.z = pk2(silu_fast(y1.x), silu_fast(y1.y)); o.w = pk2(silu_fast(y1.z), silu_fast(y1.w));
                *(u32x4*)(concat + ((size_t)(b * 2048 + t0 + t)) * 1024 + 512 + 8 * lane) = o; }
            __syncthreads();
        }
    }
    SEAM(4);
    if (IN(5)) {
        const int h = lane >> 3, l8 = lane & 7;
        const f32x4 kg0 = *(const f32x4*)(a_kg + 8 * l8), kg1 = *(const f32x4*)(a_kg + 8 * l8 + 4), qg0 = *(const f32x4*)(a_qg + 8 * l8), qg1 = *(const f32x4*)(a_qg + 8 * l8 + 4);
        const f32x2 kgr1 = *(const f32x2*)(a_kg + 64 + 2 * l8), kgr2 = *(const f32x2*)(a_kg + 80 + 2 * l8), qgr1 = *(const f32x2*)(a_qg + 64 + 2 * l8), qgr2 = *(const f32x2*)(a_qg + 80 + 2 * l8);
        for (int row = gw; row < TA; row += NGW) {
            int b, key, pos; bool rope;
            if (row < T) { b = row >> 11; pos = row & 2047; key = 256 + pos; rope = true; } else { const int rc = row - T; b = rc >> 8; key = rc & 255; pos = 0; rope = false; }
            const int bh = b * 8 + h;
            f32x2 cs = (f32x2){1.f, 1.f}, sn = (f32x2){0.f, 0.f};
            if (rope) { cs = *(const f32x2*)(ropec + pos * 16 + 2 * l8); sn = *(const f32x2*)(ropes + pos * 16 + 2 * l8); }
            {
                const u32x4 kw = *(const u32x4*)(kvraw + (size_t)row * 1024 + h * 128 + 8 * l8);
                const f32x2 x1 = *(const f32x2*)(krb + (size_t)row * 32 + 2 * l8), x2 = *(const f32x2*)(krb + (size_t)row * 32 + 16 + 2 * l8);
                float v[8];
#pragma unroll
                for (int j = 0; j < 4; ++j) { v[2 * j] = bflo(kw[j]); v[2 * j + 1] = bfhi(kw[j]); }
                float ss = (x1.x * x1.x + x1.y * x1.y) + (x2.x * x2.x + x2.y * x2.y);
#pragma unroll
                for (int j = 0; j < 8; ++j) ss += v[j] * v[j];
                ss += __shfl_xor(ss, 1); ss += __shfl_xor(ss, 2); ss += __shfl_xor(ss, 4);
                const float rstd = 1.0f / sqrtf(ss * (1.0f / 96.0f) + 1e-6f);
                bf16_t* ko = Kb + ((size_t)bh * NK + key) * 96;
                u32x4 o; o.x = pk2(v[0] * rstd * kg0.x, v[1] * rstd * kg0.y); o.y = pk2(v[2] * rstd * kg0.z, v[3] * rstd * kg0.w); o.z = pk2(v[4] * rstd * kg1.x, v[5] * rstd * kg1.y); o.w = pk2(v[6] * rstd * kg1.z, v[7] * rstd * kg1.w);
                *(u32x4*)(ko + 8 * l8) = o;
                const f32x2 a1 = x1 * rstd * kgr1, a2 = x2 * rstd * kgr2;
                const f32x2 o1 = a1 * cs - a2 * sn, o2 = a1 * sn + a2 * cs;
                *(unsigned*)(ko + 64 + 2 * l8) = pk2(o1.x, o1.y); *(unsigned*)(ko + 80 + 2 * l8) = pk2(o2.x, o2.y);
                *(u32x4*)(Vb + ((size_t)bh * NK + key) * 64 + 8 * l8) = *(const u32x4*)(kvraw + (size_t)row * 1024 + h * 128 + 64 + 8 * l8);
            }
            if (row < T) {
                const bf16_t* qp = qraw + (size_t)row * 768 + h * 96;
                const u32x4 qw = *(const u32x4*)(qp + 8 * l8); const unsigned r1 = *(const unsigned*)(qp + 64 + 2 * l8), r2 = *(const unsigned*)(qp + 80 + 2 * l8);
                float v[8];
#pragma unroll
                for (int j = 0; j < 4; ++j) { v[2 * j] = bflo(qw[j]); v[2 * j + 1] = bfhi(qw[j]); }
                const f32x2 x1 = (f32x2){bflo(r1), bfhi(r1)}, x2 = (f32x2){bflo(r2), bfhi(r2)};
                float ss = (x1.x * x1.x + x1.y * x1.y) + (x2.x * x2.x + x2.y * x2.y);
#pragma unroll
                for (int j = 0; j < 8; ++j) ss += v[j] * v[j];
                ss += __shfl_xor(ss, 1); ss += __shfl_xor(ss, 2); ss += __shfl_xor(ss, 4);
                const float rstd = QSCALE / sqrtf(ss * (1.0f / 96.0f) + 1e-6f);
                bf16_t* qo = Qb + ((size_t)bh * 2048 + pos) * 96;
                u32x4 o; o.x = pk2(v[0] * rstd * qg0.x, v[1] * rstd * qg0.y); o.y = pk2(v[2] * rstd * qg0.z, v[3] * rstd * qg0.w); o.z = pk2(v[4] * rstd * qg1.x, v[5] * rstd * qg1.y); o.w = pk2(v[6] * rstd * qg1.z, v[7] * rstd * qg1.w);
                *(u32x4*)(qo + 8 * l8) = o;
                const f32x2 a1 = x1 * rstd * qgr1, a2 = x2 * rstd * qgr2;
                const f32x2 o1 = a1 * cs - a2 * sn, o2 = a1 * sn + a2 * cs;
                *(unsigned*)(qo + 64 + 2 * l8) = pk2(o1.x, o1.y); *(unsigned*)(qo + 80 + 2 * l8) = pk2(o2.x, o2.y);
            }
        }
    }
    SEAM(5);
    if (IN(6)) {
        const int vcu = (G % 8 == 0) ? (bx % 8) * (G / 8) + bx / 8 : bx;
        for (int U = vcu; U < 1024; U += G) att::attn_unit(U >> 3, U & 7, Qb, Kb, Vb, concat, lds);
        asm volatile("s_waitcnt vmcnt(0) lgkmcnt(0)\n\ts_barrier" ::: "memory");
    }
    SEAM(6);
    if (IN(7)) {
        pg8::Gemm g{concat, WOUT_T, 1024, 1024, 1024, 0}; pg8::StaticOrder S; S.init(T, 1024, G, bx);
        pg8::EpiResid E{x, xres, mod + 2048, 6144};
        pg8::gemm_phase<pg8::EpiResid, pg8::StaticOrder, false>(lds, g, S, E, nullptr);
    }
    SEAM(7);

    layer_tail<0>(a, lds, bar);
    layer_tail<1>(a, lds, bar);
}
#undef IN
#undef SEAM

extern "C" void kernel_launch(void* const* d_in, const int* in_sizes, int n_in, void* d_out, int out_size, void* d_ws, size_t ws_size, hipStream_t stream) {
    using namespace cfg;
    static int grid = 0;
    if (grid == 0) {
        if (n_in != 34 || out_size != T * D || ws_size < WS_NEED) { fprintf(stderr, "kernel_launch: unexpected problem shape or workspace (%d inputs, out %d, ws %zu)\n", n_in, out_size, ws_size); grid = -1; return; }
        int dev = 0, cus = 0, per_cu = 0;
        if (hipGetDevice(&dev) != hipSuccess || hipDeviceGetAttribute(&cus, hipDeviceAttributeMultiprocessorCount, dev) != hipSuccess) { grid = -1; return; }
        if (hipFuncSetAttribute((const void*)fwd, hipFuncAttributeMaxDynamicSharedMemorySize, LDS_BYTES) != hipSuccess) { fprintf(stderr, "kernel_launch: hipFuncSetAttribute failed\n"); grid = -1; return; }
        if (hipOccupancyMaxActiveBlocksPerMultiprocessor(&per_cu, (const void*)fwd, 512, LDS_BYTES) != hipSuccess || per_cu < 1) { fprintf(stderr, "kernel_launch: occupancy query reports %d\n", per_cu); }
        (void)hipGetLastError();
        grid = cus;
    }
    if (grid < 0) return;
    (void)hipMemsetAsync((char*)d_ws + OFF_CTL, 0, CTL_BYTES, stream);
    Args a{};
    for (int i = 0; i < 34; ++i) a.in[i] = (const float*)d_in[i];
    a.out = (float*)d_out; a.ws = (unsigned char*)d_ws;
#ifndef MK_ONE_LAUNCH
#define MK_ONE_LAUNCH 0
#endif
    if (MK_ONE_LAUNCH) { a.ph_lo = 0; a.ph_hi = NPHASE; hipLaunchKernelGGL(fwd, dim3(grid), dim3(512), LDS_BYTES, stream, a); }
    else for (int p = 0; p < NPHASE; ++p) { a.ph_lo = p; a.ph_hi = p + 1; hipLaunchKernelGGL(fwd, dim3(grid), dim3(512), LDS_BYTES, stream, a); }
}
```

```cpp
#define MK_ONE_LAUNCH 1
#include <hip/hip_runtime.h>
#include <cstdint>
#include <cstdio>

#define LAS __attribute__((address_space(3)))
#define GAS __attribute__((address_space(1)))
typedef unsigned short bf16_t;
typedef short bf16x8 __attribute__((ext_vector_type(8)));
typedef float f32x4 __attribute__((ext_vector_type(4)));
typedef float f32x2 __attribute__((ext_vector_type(2)));
typedef float f32x16 __attribute__((ext_vector_type(16)));
typedef unsigned u32x4 __attribute__((ext_vector_type(4)));
typedef unsigned u32x2 __attribute__((ext_vector_type(2)));

namespace cfg {
constexpr int D = 1024, NB = 16, S = 2048, CTX = 256, NK = 2304, T = NB * S, TC = NB * CTX, TA = T + TC;
constexpr int H = 8, QL = 384, KVL = 256, AIN = 1696, AINP = 1792;
constexpr int CC = 512, CW = 31, SG = 2048, CH = 128;
constexpr int NE = 32, DE = 256, CAP_TILES = 288;
constexpr float QSCALE = 1.4426950408889634f * 0.10206207261596575f;
constexpr size_t MiB = (size_t)1 << 20;
constexpr size_t OFF_CTL = 0, CTL_BYTES = MiB;
constexpr size_t OFF_MOD = 1 * MiB, OFF_ROPE = 2 * MiB, OFF_RFRAG = 2 * MiB + 512 * 1024, OFF_RBIAS = 3 * MiB - 4096;
constexpr size_t OFF_WIN = 4 * MiB, OFF_WUQ = 7 * MiB + 512 * 1024, OFF_WUKV = 8 * MiB + 256 * 1024, OFF_WOUT = 9 * MiB, OFF_CIN = 11 * MiB, OFF_COUT = 19 * MiB, OFF_WSB = 23 * MiB;
constexpr size_t OFF_MGU = 24 * MiB, OFF_MDN = 88 * MiB;
constexpr size_t OFF_LIST = 120 * MiB, OFF_LISTW = 124 * MiB, OFF_TOKSLOT = 128 * MiB;
constexpr size_t OFF_HB = 132 * MiB, OFF_PROJ = 204 * MiB, OFF_QN = 330 * MiB, OFF_KVN = 354 * MiB, OFF_Z = 377 * MiB;
constexpr size_t OFF_QRAW = 132 * MiB, OFF_KVRAW = 204 * MiB, OFF_Q = 276 * MiB, OFF_K = 324 * MiB, OFF_V = 378 * MiB, OFF_CONCAT = 414 * MiB, OFF_KR = 478 * MiB;
constexpr size_t OFF_H2 = 132 * MiB, OFF_ACT = 196 * MiB, OFF_HE = 232 * MiB, OFF_ZZ = 196 * MiB;
constexpr size_t WS_NEED = 483 * MiB;
static_assert(OFF_MOD + (size_t)2 * 17 * 6144 * 4 <= OFF_ROPE && OFF_ROPE + 2 * 2048 * 16 * 4 <= OFF_RFRAG && OFF_RFRAG + 2 * 32 * 3 * 2 * 1024 <= OFF_RBIAS, "tables");
static_assert(OFF_WIN + (size_t)AINP * 1024 * 2 <= OFF_WUQ && OFF_WUQ + 768 * 384 * 2 <= OFF_WUKV && OFF_WUKV + 1024 * 256 * 2 <= OFF_WOUT && OFF_WOUT + 1024 * 1024 * 2 <= OFF_CIN, "weights 1");
static_assert(OFF_CIN + (size_t)4096 * 1024 * 2 <= OFF_COUT && OFF_COUT + (size_t)1024 * 2048 * 2 <= OFF_WSB && OFF_WSB + 8 * 128 * 128 * 2 <= OFF_MGU, "weights 2");
static_assert(OFF_MGU + (size_t)2 * 32 * 512 * 1024 * 2 <= OFF_MDN && OFF_MDN + (size_t)2 * 32 * 1024 * 256 * 2 <= OFF_LIST && OFF_LIST + (size_t)32 * 32768 * 4 <= OFF_LISTW && OFF_LISTW + (size_t)32 * 32768 * 4 <= OFF_TOKSLOT && OFF_TOKSLOT + (size_t)T * 2 * 4 <= OFF_HB, "moe");
static_assert(OFF_HB + (size_t)TA * 1024 * 2 <= OFF_PROJ && OFF_PROJ + (size_t)TA * AINP * 2 <= OFF_QN && OFF_QN + (size_t)T * 384 * 2 <= OFF_KVN && OFF_KVN + (size_t)TA * 256 * 2 <= OFF_Z && OFF_Z + (size_t)T * 512 * 2 <= OFF_CONCAT, "act 1");
static_assert(OFF_QRAW + (size_t)T * 768 * 2 <= OFF_KVRAW && OFF_KVRAW + (size_t)TA * 1024 * 2 <= OFF_Q && OFF_Q + (size_t)T * 768 * 2 <= OFF_K && OFF_K + (size_t)128 * NK * 96 * 2 <= OFF_V && OFF_V + (size_t)128 * NK * 64 * 2 <= OFF_CONCAT, "act 2");
static_assert(OFF_CONCAT + (size_t)T * 1024 * 2 <= OFF_KR && OFF_KR + (size_t)TA * 32 * 4 <= WS_NEED, "act 3");
static_assert(OFF_H2 + (size_t)T * 1024 * 2 <= OFF_ACT && OFF_ACT + (size_t)CAP_TILES * 256 * 256 * 2 <= OFF_HE && OFF_HE + (size_t)CAP_TILES * 256 * 1024 * 2 <= WS_NEED && OFF_ZZ + (size_t)T * 4096 * 2 <= WS_NEED, "act 4");
constexpr int CW_BAR = 4096, CW_GCNT = 8192;
constexpr int LDS_TB = 131072, LDS_CNT = LDS_TB + 256, LDS_TOKL = LDS_TB + 512, LDS_WL = LDS_TOKL + 4096, LDS_UT = LDS_WL + 4096, LDS_MISC = LDS_UT + 256, LDS_BYTES = 147456;
static_assert(LDS_MISC + 64 <= LDS_BYTES, "lds map");
constexpr int NPHASE = 19;
}
namespace pg8 {
constexpr int BM = 256, BK = 64, HALF = 128, HTB = HALF * BK * 2, STAGE_BYTES = 8 * HTB, NXCD = 8, WGM = 8;
__host__ __device__ __forceinline__ int lds_byte(int r, int c) { const int st = (r >> 4) * 2 + (c >> 5), rr = r & 15, cc = c & 31, ob = rr * 64 + cc * 2; return st * 1024 + (ob ^ (((ob >> 9) & 1) << 5)); }
__host__ __device__ __forceinline__ void stage_rc(int b, int& R, int& C) { const int st = b / 1024, sb = b % 1024, swz = sb ^ (((sb >> 9) & 1) << 5); R = (st >> 1) * 16 + swz / 64; C = (st & 1) * 32 + (swz % 64) / 2; }
__host__ __device__ __forceinline__ int perm32(int rho) { const int n = rho >> 4, i = rho & 15; return 8 * (i >> 2) + 4 * n + (i & 3); }

struct Unit { int pm, pn, eb, aux; };
struct Gemm { const bf16_t* A; const bf16_t* Bt; int lda, ldb, K; size_t bstride; };

struct StaticOrder {
    int nM, nN, nwg, G, c;
    __device__ __forceinline__ void init(int M, int N, int G_, int c_) { nM = M / BM; nN = N / BM; nwg = nM * nN; G = G_; c = c_; }
    __device__ __forceinline__ bool next(int i, Unit& u) const {
        const long L = (long)i * G + c; if (L >= nwg) return false;
        int wgid = (int)L; { const int q = nwg / NXCD, r = nwg % NXCD, xcd = wgid % NXCD, off = wgid / NXCD; wgid = (xcd < r ? xcd * (q + 1) : r * (q + 1) + (xcd - r) * q) + off; }
        const int nig = WGM * nN, gid = wgid / nig, fm = gid * WGM, gsz = (nM - fm) < WGM ? (nM - fm) : WGM;
        u.pm = fm + ((wgid % nig) % gsz); u.pn = (wgid % nig) / gsz; u.eb = 0; u.aux = 0; return true;
    }
};
struct GroupedOrder {
    const volatile LAS int* ut; int n;
    __device__ __forceinline__ bool next(int i, Unit& u) const {
        if (i >= n) return false;
        u.pm = __builtin_amdgcn_readfirstlane(ut[4 * i]); u.pn = __builtin_amdgcn_readfirstlane(ut[4 * i + 1]); u.eb = __builtin_amdgcn_readfirstlane(ut[4 * i + 2]); u.aux = __builtin_amdgcn_readfirstlane(ut[4 * i + 3]); return true;
    }
};
__device__ __forceinline__ void build_units(volatile LAS int* ut, const LAS int* tb, int ncol, int G, int c) {
    const int nunits = tb[32] * ncol; int n = 0;
    for (int i = 0; i < 8; ++i) { const int L = i * G + c; if (L >= nunits) break; const int rt = L / ncol; int e = 0;
        for (int k = 1; k < 32; ++k) if (tb[k] <= rt) e = k;
        ut[4 * i] = rt; ut[4 * i + 1] = L - rt * ncol; ut[4 * i + 2] = e; ut[4 * i + 3] = rt - tb[e]; n = i + 1; }
    ut[32] = n;
}

__device__ __forceinline__ unsigned cvt_pk_bf16(float lo, float hi) { unsigned r; asm volatile("v_cvt_pk_bf16_f32 %0, %1, %2" : "=v"(r) : "v"(lo), "v"(hi)); return r; }
__device__ __forceinline__ float gelu_tanh_f(float v) { const float t = v * (-2.302208198f + -0.1029432397f * v * v); return v * __builtin_amdgcn_rcpf(1.0f + __builtin_amdgcn_exp2f(t)); }

template <int ACT> struct EpiBf16 {
    static constexpr bool PERM = true;
    bf16_t* O; int ldc; const float* bias;
    __device__ __forceinline__ void operator()(const f32x4 (&acc)[2][2][4][2], const Unit& u, int ui, int wr, int wc, int fr, int fq) const {
        const int row0 = u.pm * BM + wr * 64 + fr; const int col0 = u.pn * BM + wc * 32 + 8 * fq;
        f32x4 bv[2][2];
#pragma unroll
        for (int bj = 0; bj < 2; ++bj)
#pragma unroll
            for (int n = 0; n < 2; ++n) bv[bj][n] = bias ? *(const f32x4*)(bias + col0 + bj * HALF + 4 * n) : (f32x4){0.f, 0.f, 0.f, 0.f};
#pragma unroll
        for (int ai = 0; ai < 2; ++ai)
#pragma unroll
            for (int m = 0; m < 4; ++m) { bf16_t* rowp = O + (size_t)(row0 + ai * HALF + m * 16) * ldc + col0;
#pragma unroll
                for (int bj = 0; bj < 2; ++bj) { f32x4 v0 = acc[ai][bj][m][0] + bv[bj][0], v1 = acc[ai][bj][m][1] + bv[bj][1];
                    if (ACT == 1) {
#pragma unroll
                        for (int j = 0; j < 4; ++j) { v0[j] = gelu_tanh_f(v0[j]); v1[j] = gelu_tanh_f(v1[j]); } }
                    u32x4 w; w.x = cvt_pk_bf16(v0[0], v0[1]); w.y = cvt_pk_bf16(v0[2], v0[3]); w.z = cvt_pk_bf16(v1[0], v1[1]); w.w = cvt_pk_bf16(v1[2], v1[3]);
                    *(u32x4*)(rowp + bj * HALF) = w; } }
    }
};
struct EpiResid {
    static constexpr bool PERM = false;
    const float* xi; float* xo; const float* gate; int gstride;
    __device__ __forceinline__ void operator()(const f32x4 (&acc)[2][2][4][2], const Unit& u, int ui, int wr, int wc, int fr, int fq) const {
        const int row0 = u.pm * BM + wr * 64 + fr, col0 = u.pn * BM + wc * 32 + 4 * fq;
        const float* gp = gate + (size_t)((u.pm * BM) >> 11) * gstride + col0;
        f32x4 gv[2][2];
#pragma unroll
        for (int bj = 0; bj < 2; ++bj)
#pragma unroll
            for (int n = 0; n < 2; ++n) gv[bj][n] = *(const f32x4*)(gp + bj * HALF + n * 16);
#pragma unroll
        for (int ai = 0; ai < 2; ++ai)
#pragma unroll
            for (int m = 0; m < 4; ++m) { const size_t off = (size_t)(row0 + ai * HALF + m * 16) * 1024 + col0;
#pragma unroll
                for (int bj = 0; bj < 2; ++bj)
#pragma unroll
                    for (int n = 0; n < 2; ++n) { const f32x4 xv = *(const f32x4*)(xi + off + bj * HALF + n * 16); *(f32x4*)(xo + off + bj * HALF + n * 16) = xv + gv[bj][n] * acc[ai][bj][m][n]; } }
    }
};
struct EpiAct {
    static constexpr bool PERM = false;
    bf16_t* O; const LAS float* wl;
    __device__ __forceinline__ void operator()(const f32x4 (&acc)[2][2][4][2], const Unit& u, int ui, int wr, int wc, int fr, int fq) const {
        const int col0 = u.pn * HALF + wc * 32 + 4 * fq;
#pragma unroll
        for (int ai = 0; ai < 2; ++ai)
#pragma unroll
            for (int m = 0; m < 4; ++m) { const int rt = ai * HALF + wr * 64 + m * 16 + fr; const float w = wl[ui * 256 + rt];
                bf16_t* rowp = O + (size_t)(u.pm * BM + rt) * 256 + col0;
#pragma unroll
                for (int n = 0; n < 2; ++n) { const f32x4 g = acc[ai][0][m][n], up = acc[ai][1][m][n]; f32x4 r;
#pragma unroll
                    for (int j = 0; j < 4; ++j) r[j] = w * up[j] * g[j] * __builtin_amdgcn_rcpf(1.0f + __builtin_amdgcn_exp2f(-1.4426950409f * g[j]));
                    u32x2 o; o.x = cvt_pk_bf16(r[0], r[1]); o.y = cvt_pk_bf16(r[2], r[3]); *(u32x2*)(rowp + n * 16) = o; } }
    }
};

template <class Epi, class Sched, bool GATHER>
__device__ __forceinline__ void gemm_phase(LAS unsigned char* lds, const Gemm g, const Sched& S, const Epi& E, const LAS int* tokl) {
    const int tid = threadIdx.x, wid = __builtin_amdgcn_readfirstlane(tid >> 6), lane = tid & 63, wr = wid >> 2, wc = wid & 3, fr = lane & 15, fq = lane >> 4;
    const int K = g.K, nt = K / BK;
    const size_t kstep = (size_t)(BK * 2);
    const size_t hstepB = (size_t)HALF * g.ldb * 2, tstepB = 2 * hstepB;
    const unsigned hstepA = (unsigned)HALF * g.lda * 2; const size_t tstepA = 2 * (size_t)hstepA;
    int Rs[2], Cs[2]; unsigned voffB[2];
#pragma unroll
    for (int i = 0; i < 2; ++i) { int R, C; stage_rc(tid * 16 + i * 8192, R, C); Rs[i] = R; Cs[i] = C; const int Rb = Epi::PERM ? ((R & ~31) + perm32(R & 31)) : R; voffB[i] = (unsigned)(Rb * g.ldb + C) * 2u; }
    unsigned offA[2][2], noffA[2][2];
#define PG8_SETOFF(dst, UI) do { _Pragma("unroll") for (int _h = 0; _h < 2; ++_h) _Pragma("unroll") for (int _i = 0; _i < 2; ++_i) { \
        if (GATHER) dst[_h][_i] = (unsigned)tokl[(UI) * 256 + _h * HALF + Rs[_i]] * (unsigned)(g.lda * 2) + (unsigned)Cs[_i] * 2u; \
        else dst[_h][_i] = (unsigned)_h * hstepA + (unsigned)(Rs[_i] * g.lda + Cs[_i]) * 2u; } } while (0)
    const unsigned ldsw = (unsigned)wid * 1024u;
    const int aoff = lds_byte(wr * 64 + fr, fq * 8), boff = lds_byte(wc * 32 + fr, fq * 8);
#define PG8_SA(b, h) (((b) * 2 + (h)) * HTB)
#define PG8_SB(b, h) ((4 + (b) * 2 + (h)) * HTB)
#define PG8_STAGE(bufoff, gbase, voff) do { _Pragma("unroll") for (int _i = 0; _i < 2; ++_i) \
        __builtin_amdgcn_global_load_lds((const unsigned*)((const char*)(gbase) + (voff)[_i]), (LAS unsigned*)(lds + (bufoff) + ldsw + _i * 8192), 16, 0, 0); } while (0)
#define PG8_LDA(dst, b, h) do { _Pragma("unroll") for (int m = 0; m < 4; ++m) _Pragma("unroll") for (int k = 0; k < 2; ++k) dst[m][k] = *(const LAS bf16x8*)(lds + PG8_SA(b, h) + aoff + m * 2048 + k * 1024); } while (0)
#define PG8_LDB(dst, b, h) do { _Pragma("unroll") for (int n = 0; n < 2; ++n) _Pragma("unroll") for (int k = 0; k < 2; ++k) dst[n][k] = *(const LAS bf16x8*)(lds + PG8_SB(b, h) + boff + n * 2048 + k * 1024); } while (0)
#define PG8_MMA(ai, bj, At, Bt) do { __builtin_amdgcn_s_setprio(1); _Pragma("unroll") for (int m = 0; m < 4; ++m) _Pragma("unroll") for (int n = 0; n < 2; ++n) _Pragma("unroll") for (int k = 0; k < 2; ++k) \
        acc[ai][bj][m][n] = __builtin_amdgcn_mfma_f32_16x16x32_bf16(Bt[n][k], At[m][k], acc[ai][bj][m][n], 0, 0, 0); __builtin_amdgcn_s_setprio(0); } while (0)
#define PG8_WAIT_V(n) asm volatile("s_waitcnt vmcnt(" #n ")" ::: "memory")
#define PG8_WAIT_L(n) asm volatile("s_waitcnt lgkmcnt(" #n ")" ::: "memory")
#define PG8_BAR __builtin_amdgcn_s_barrier()
#define PG8_SCHED __builtin_amdgcn_sched_barrier(0)
    Unit cur, nxt; int ui = 0;
    if (!S.next(0, cur)) return;
    f32x4 acc[2][2][4][2];
#pragma unroll
    for (int a = 0; a < 2; ++a)
#pragma unroll
        for (int b = 0; b < 2; ++b)
#pragma unroll
            for (int m = 0; m < 4; ++m)
#pragma unroll
                for (int n = 0; n < 2; ++n) acc[a][b][m][n] = (f32x4){0.f, 0.f, 0.f, 0.f};
    bf16x8 At[4][2], B0[2][2], B1[2][2];
    const char* cA = GATHER ? (const char*)g.A : (const char*)g.A + (size_t)cur.pm * tstepA;
    const char* cB = (const char*)g.Bt + ((size_t)cur.eb * g.bstride) * 2 + (size_t)cur.pn * tstepB;
    PG8_SETOFF(offA, 0);
#pragma unroll
    for (int _h = 0; _h < 2; ++_h)
#pragma unroll
        for (int _i = 0; _i < 2; ++_i) noffA[_h][_i] = offA[_h][_i];
    PG8_STAGE(PG8_SB(0, 0), cB, voffB); PG8_STAGE(PG8_SB(0, 1), cB + hstepB, voffB); PG8_STAGE(PG8_SA(0, 0), cA, offA[0]); PG8_STAGE(PG8_SA(0, 1), cA, offA[1]);
    if (wr == 1) PG8_BAR;
    PG8_WAIT_V(2); PG8_BAR;
    PG8_STAGE(PG8_SB(1, 0), cB + kstep, voffB); PG8_STAGE(PG8_SA(1, 0), cA + kstep, offA[0]); PG8_STAGE(PG8_SB(1, 1), cB + hstepB + kstep, voffB);
    PG8_WAIT_V(6); PG8_BAR;
    for (;;) {
        const bool has_next = S.next(ui + 1, nxt);
        const char* nA = has_next ? (GATHER ? (const char*)g.A : (const char*)g.A + (size_t)nxt.pm * tstepA) : cA;
        const char* nB = has_next ? (const char*)g.Bt + ((size_t)nxt.eb * g.bstride) * 2 + (size_t)nxt.pn * tstepB : cB;
        if (GATHER && has_next) PG8_SETOFF(noffA, ui + 1);
#pragma unroll 1
        for (int t = 0; t < nt; t += 2) {
            const bool last = (t == nt - 2);
            const char* a1 = cA + (size_t)(t + 1) * kstep;
            const char* a2 = last ? nA : cA + (size_t)(t + 2) * kstep; const char* b2 = last ? nB : cB + (size_t)(t + 2) * kstep;
            const char* a3 = a2 + kstep; const char* b3 = b2 + kstep;
            unsigned o2[2][2];
#pragma unroll
            for (int _h = 0; _h < 2; ++_h)
#pragma unroll
                for (int _i = 0; _i < 2; ++_i) o2[_h][_i] = (GATHER && last) ? noffA[_h][_i] : offA[_h][_i];
            PG8_LDB(B0, 0, 0); PG8_LDB(B1, 0, 1); PG8_SCHED; PG8_LDA(At, 0, 0); PG8_STAGE(PG8_SA(1, 1), a1, offA[1]);
            PG8_WAIT_V(8); PG8_WAIT_L(0); PG8_BAR; PG8_MMA(0, 0, At, B0); PG8_MMA(0, 1, At, B1); PG8_BAR; PG8_SCHED;
            PG8_LDA(At, 0, 1); PG8_STAGE(PG8_SB(0, 0), b2, voffB); PG8_STAGE(PG8_SB(0, 1), b2 + hstepB, voffB); PG8_STAGE(PG8_SA(0, 0), a2, o2[0]);
            PG8_WAIT_V(8); PG8_WAIT_L(0); PG8_BAR; PG8_MMA(1, 0, At, B0); PG8_MMA(1, 1, At, B1); PG8_BAR; PG8_SCHED;
            PG8_LDB(B0, 1, 0); PG8_LDB(B1, 1, 1); PG8_SCHED; PG8_LDA(At, 1, 0); PG8_STAGE(PG8_SA(0, 1), a2, o2[1]);
            PG8_WAIT_V(8); PG8_WAIT_L(0); PG8_BAR; PG8_MMA(0, 0, At, B0); PG8_MMA(0, 1, At, B1); PG8_BAR; PG8_SCHED;
            PG8_LDA(At, 1, 1); PG8_STAGE(PG8_SB(1, 0), b3, voffB); PG8_STAGE(PG8_SB(1, 1), b3 + hstepB, voffB); PG8_STAGE(PG8_SA(1, 0), a3, o2[0]);
            PG8_WAIT_V(8); PG8_WAIT_L(0); PG8_BAR; PG8_MMA(1, 0, At, B0); PG8_MMA(1, 1, At, B1); PG8_BAR; PG8_SCHED;
        }
        if (wr == 0) PG8_BAR;
        E(acc, cur, ui, wr, wc, fr, fq);
        if (!has_next) break;
#pragma unroll
        for (int a = 0; a < 2; ++a)
#pragma unroll
            for (int b = 0; b < 2; ++b)
#pragma unroll
                for (int m = 0; m < 4; ++m)
#pragma unroll
                    for (int n = 0; n < 2; ++n) acc[a][b][m][n] = (f32x4){0.f, 0.f, 0.f, 0.f};
        cur = nxt; cA = nA; cB = nB; ++ui;
        if (GATHER) {
#pragma unroll
            for (int _h = 0; _h < 2; ++_h)
#pragma unroll
                for (int _i = 0; _i < 2; ++_i) offA[_h][_i] = noffA[_h][_i]; }
        if (wr == 1) PG8_BAR;
    }
    PG8_WAIT_V(0);
    PG8_BAR;
#undef PG8_SETOFF
#undef PG8_SA
#undef PG8_SB
#undef PG8_STAGE
#undef PG8_LDA
#undef PG8_LDB
#undef PG8_MMA
#undef PG8_WAIT_V
#undef PG8_WAIT_L
#undef PG8_BAR
#undef PG8_SCHED
}
}
namespace att {
constexpr int NKEY = 2304, KT = 64, NT = NKEY / KT, KSLOT = 12288, VSLOT = 8192;
constexpr int LDS_K = 0, LDS_V = 2 * KSLOT, LDS_WS = LDS_V + 2 * VSLOT, LDS_BYTES = LDS_WS + 8 * 256;
__device__ __forceinline__ int crow(int r, int hi) { return (r & 3) + 8 * (r >> 2) + 4 * hi; }
typedef short s16x4 __attribute__((ext_vector_type(4)));
__device__ __forceinline__ unsigned cvtpk(float lo, float hi) { unsigned r; asm volatile("v_cvt_pk_bf16_f32 %0, %1, %2" : "=v"(r) : "v"(lo), "v"(hi)); return r; }

__device__ __forceinline__ void attn_unit(int bh, int qb, const bf16_t* Q, const bf16_t* K, const bf16_t* V, bf16_t* concat, LAS unsigned char* lds) {
    const int tid = threadIdx.x, lane = tid & 63, r32 = lane & 31, hi = lane >> 5; const int wid = __builtin_amdgcn_readfirstlane(tid >> 6);
    const bf16_t* Qw = Q + ((size_t)bh * 2048 + qb * 256 + wid * 32) * 96;
    const bf16_t* Kh = K + (size_t)bh * NKEY * 96; const bf16_t* Vh = V + (size_t)bh * NKEY * 64;
    LAS float* wsf = (LAS float*)(lds + LDS_WS) + wid * 64;
    const bf16_t* ksrc0 = Kh + (size_t)lane * 96 + wid * 8;
    const bf16_t* ksrc1 = Kh + (size_t)lane * 96 + (8 + (wid & 3)) * 8;
    const bf16_t* vsrc = Vh + (size_t)(16 * (wid & 3) + (lane >> 2)) * 64 + (wid >> 2) * 32 + (lane & 3) * 8;
#define ATT_DMA(t, slot) do { \
        __builtin_amdgcn_global_load_lds((const unsigned*)(ksrc0 + (size_t)(t) * KT * 96), (LAS unsigned*)(lds + LDS_K + (slot) * KSLOT + wid * 1024), 16, 0, 0); \
        if (wid < 4) __builtin_amdgcn_global_load_lds((const unsigned*)(ksrc1 + (size_t)(t) * KT * 96), (LAS unsigned*)(lds + LDS_K + (slot) * KSLOT + (8 + wid) * 1024), 16, 0, 0); \
        __builtin_amdgcn_global_load_lds((const unsigned*)(vsrc + (size_t)(t) * KT * 64), (LAS unsigned*)(lds + LDS_V + (slot) * VSLOT + wid * 1024), 16, 0, 0); } while (0)
    ATT_DMA(0, 0);
    bf16x8 qr[6];
#pragma unroll
    for (int d0 = 0; d0 < 6; ++d0) qr[d0] = *(const bf16x8*)(Qw + (size_t)r32 * 96 + d0 * 16 + hi * 8);
    float m_run = -1e30f, l_run = 0.f; f32x16 o[2]; o[0] = (f32x16){}; o[1] = (f32x16){};
    const int kfo = hi * 1024 + r32 * 16;
    const int vfo = ((lane >> 4) & 1) * 32 + (lane & 3) * 8 + (4 * hi + ((lane & 15) >> 2)) * 64;
#pragma unroll 1
    for (int t = 0; t < NT; ++t) {
        asm volatile("s_waitcnt vmcnt(0)\n\ts_barrier" ::: "memory");
        const int slot = t & 1;
        if (t + 1 < NT) ATT_DMA(t + 1, slot ^ 1);
        const LAS unsigned char* kb = lds + LDS_K + slot * KSLOT + kfo;
        f32x16 p0 = (f32x16){}, p1 = (f32x16){};
#pragma unroll
        for (int d0 = 0; d0 < 6; ++d0) {
            const bf16x8 k0 = *(const LAS bf16x8*)(kb + d0 * 2048);
            const bf16x8 k1 = *(const LAS bf16x8*)(kb + d0 * 2048 + 512);
            p0 = __builtin_amdgcn_mfma_f32_32x32x16_bf16(k0, qr[d0], p0, 0, 0, 0);
            p1 = __builtin_amdgcn_mfma_f32_32x32x16_bf16(k1, qr[d0], p1, 0, 0, 0);
        }
        float mx = p0[0];
#pragma unroll
        for (int r = 1; r < 16; ++r) mx = fmaxf(mx, p0[r]);
#pragma unroll
        for (int r = 0; r < 16; ++r) mx = fmaxf(mx, p1[r]);
        mx = fmaxf(mx, __shfl_xor(mx, 32));
        const float m_new = fmaxf(m_run, mx);
        const float alpha = __builtin_amdgcn_exp2f(m_run - m_new);
        const bool changed = !__all(m_new == m_run);
        m_run = m_new;
        float ls = 0.f;
#pragma unroll
        for (int r = 0; r < 16; ++r) { p0[r] = __builtin_amdgcn_exp2f(p0[r] - m_new); p1[r] = __builtin_amdgcn_exp2f(p1[r] - m_new); ls += p0[r] + p1[r]; }
        l_run = l_run * alpha + ls;
        if (changed) {
            if (hi == 0) wsf[r32] = alpha;
            asm volatile("s_waitcnt lgkmcnt(0)" ::: "memory");
#pragma unroll
            for (int r = 0; r < 16; ++r) { const float a = wsf[crow(r, hi)]; o[0][r] *= a; o[1][r] *= a; }
        }
        u32x4 pw[4];
        pw[0] = (u32x4){cvtpk(p0[0], p0[1]), cvtpk(p0[2], p0[3]), cvtpk(p0[4], p0[5]), cvtpk(p0[6], p0[7])};
        pw[1] = (u32x4){cvtpk(p0[8], p0[9]), cvtpk(p0[10], p0[11]), cvtpk(p0[12], p0[13]), cvtpk(p0[14], p0[15])};
        pw[2] = (u32x4){cvtpk(p1[0], p1[1]), cvtpk(p1[2], p1[3]), cvtpk(p1[4], p1[5]), cvtpk(p1[6], p1[7])};
        pw[3] = (u32x4){cvtpk(p1[8], p1[9]), cvtpk(p1[10], p1[11]), cvtpk(p1[12], p1[13]), cvtpk(p1[14], p1[15])};
        const LAS unsigned char* vp = lds + LDS_V + slot * VSLOT + vfo;
#pragma unroll
        for (int d0 = 0; d0 < 2; ++d0)
#pragma unroll
            for (int ks = 0; ks < 4; ++ks) {
                const s16x4 lo = __builtin_bit_cast(s16x4, __builtin_amdgcn_ds_read_tr16_b64_v4i16((LAS s16x4*)(vp + d0 * 4096 + ks * 1024)));
                const s16x4 hh = __builtin_bit_cast(s16x4, __builtin_amdgcn_ds_read_tr16_b64_v4i16((LAS s16x4*)(vp + d0 * 4096 + ks * 1024 + 512)));
                const bf16x8 vf = (bf16x8){lo[0], lo[1], lo[2], lo[3], hh[0], hh[1], hh[2], hh[3]};
                o[d0] = __builtin_amdgcn_mfma_f32_32x32x16_bf16(__builtin_bit_cast(bf16x8, pw[ks]), vf, o[d0], 0, 0, 0);
            }
    }
    l_run += __shfl_xor(l_run, 32);
    if (hi == 0) wsf[32 + r32] = l_run;
    asm volatile("s_waitcnt lgkmcnt(0)" ::: "memory");
    const int b = bh >> 3, h = bh & 7;
    bf16_t* Ow = concat + ((size_t)b * 2048 + qb * 256 + wid * 32) * 1024 + h * 64 + r32;
#pragma unroll
    for (int r = 0; r < 16; ++r) { const int q = crow(r, hi); const float rl = __builtin_amdgcn_rcpf(wsf[32 + q]);
        const unsigned w = cvtpk(o[0][r] * rl, o[1][r] * rl);
        Ow[(size_t)q * 1024] = (bf16_t)(w & 0xffffu); Ow[(size_t)q * 1024 + 32] = (bf16_t)(w >> 16); }
#undef ATT_DMA
}
}
__device__ __forceinline__ float wave_sum(float v) {
#pragma unroll
    for (int o = 1; o < 64; o <<= 1) v += __shfl_xor(v, o);
    return v;
}
__device__ __forceinline__ float bf2f(unsigned short b) { return __uint_as_float(((unsigned)b) << 16); }
__device__ __forceinline__ float bflo(unsigned w) { return __uint_as_float(w << 16); }
__device__ __forceinline__ float bfhi(unsigned w) { return __uint_as_float(w & 0xffff0000u); }
__device__ __forceinline__ unsigned pk2(float lo, float hi) { return pg8::cvt_pk_bf16(lo, hi); }
__device__ __forceinline__ float silu_fast(float v) { return v * __builtin_amdgcn_rcpf(1.0f + __builtin_amdgcn_exp2f(-1.4426950409f * v)); }
__device__ __forceinline__ float sigmoid_fast(float v) { return __builtin_amdgcn_rcpf(1.0f + __builtin_amdgcn_exp2f(-1.4426950409f * v)); }

__device__ __forceinline__ void transpose_item(const float* W, int ldw, int k0, int n0, bf16_t* WT, int ldt, int dst_row0, const float* kscale, LAS float* scr, int lane) {
#pragma unroll 8
    for (int i = 0; i < 32; ++i) { const int kk = 2 * i + (lane >> 5); float v = W[(size_t)(k0 + kk) * ldw + n0 + (lane & 31)]; if (kscale) v *= kscale[k0 + kk]; scr[kk * 33 + (lane & 31)] = v; }
    asm volatile("s_waitcnt lgkmcnt(0)" ::: "memory");
    const int c = lane & 7;
#pragma unroll
    for (int j = 0; j < 4; ++j) { const int n = (lane >> 3) + 8 * j; const LAS float* s = scr + (8 * c) * 33 + n;
        u32x4 o; o.x = pk2(s[0 * 33], s[1 * 33]); o.y = pk2(s[2 * 33], s[3 * 33]); o.z = pk2(s[4 * 33], s[5 * 33]); o.w = pk2(s[6 * 33], s[7 * 33]);
        *(u32x4*)(WT + (size_t)(dst_row0 + n) * ldt + k0 + 8 * c) = o; }
    asm volatile("s_waitcnt lgkmcnt(0)" ::: "memory");
}

__device__ __forceinline__ void norm_mod_row(const float* xr, const float* g, const float* shift, const float* scale, bf16_t* orow, int lane) {
    f32x4 v[4]; float ss = 0.f;
#pragma unroll
    for (int j = 0; j < 4; ++j) { v[j] = *(const f32x4*)(xr + 4 * lane + 256 * j); ss += (v[j].x * v[j].x + v[j].y * v[j].y) + (v[j].z * v[j].z + v[j].w * v[j].w); }
    const float rstd = 1.0f / sqrtf(wave_sum(ss) * (1.0f / 1024.0f) + 1e-6f);
#pragma unroll
    for (int j = 0; j < 4; ++j) { const int c = 4 * lane + 256 * j; const f32x4 gg = *(const f32x4*)(g + c), sc = *(const f32x4*)(scale + c), sh = *(const f32x4*)(shift + c);
        const f32x4 y = v[j] * rstd * gg * (sc + 1.0f) + sh; u32x2 o; o.x = pk2(y.x, y.y); o.y = pk2(y.z, y.w); *(u32x2*)(orow + c) = o; }
}
#define XB_TMO      128
#define XB_XCNT(j)  (256  + 64 * (j))
#define XB_XSUB(j)  (1280 + 64 * (j))
#define XB_XGEN(j)  (2304 + 64 * (j))
#define XB_TOP      3328
#define XB_TOPGEN   3392
#define XCD_BAR_WORDS 3456
#define XB_SPIN_CAP (1u << 18)
__device__ __forceinline__ unsigned xb_ld(unsigned* p)              { return __hip_atomic_load(p, __ATOMIC_RELAXED, __HIP_MEMORY_SCOPE_AGENT); }
__device__ __forceinline__ unsigned xb_add(unsigned* p, unsigned v) { return __hip_atomic_fetch_add(p, v, __ATOMIC_RELAXED, __HIP_MEMORY_SCOPE_AGENT); }
__device__ __forceinline__ unsigned xb_xcc_id() { return (unsigned)__builtin_amdgcn_s_getreg((3 << 11) | 20) & 0xFu; }
#define XB_SPIN(cond, bar) do { unsigned _sp = 0; while (cond) { __builtin_amdgcn_s_sleep(1); \
    if ((++_sp & 255u) == 0u) { if (xb_ld(&(bar)[XB_TMO])) break; if (_sp > XB_SPIN_CAP) { atomicAdd(&(bar)[XB_TMO], 1u); break; } } } } while (0)
struct XcdBarrier { unsigned* bar; unsigned x; volatile LAS unsigned* st; };
__device__ __forceinline__ XcdBarrier xcd_barrier_post(unsigned* bar, volatile LAS unsigned* st) {
    XcdBarrier b; b.bar = bar; b.x = xb_xcc_id(); b.st = st;
    if (threadIdx.x == 0) (void)xb_add(&bar[XB_XCNT(b.x)], 1u);
    return b;
}
__device__ __forceinline__ void xcd_barrier_complete(unsigned* bar, unsigned x, unsigned& nloc, unsigned& nx) {
    const unsigned G = gridDim.x * gridDim.y * gridDim.z;
    unsigned sum, cnt, mine, sp = 0u;
    for (;;) {
        sum = 0u; cnt = 0u; mine = 0u;
#pragma unroll
        for (unsigned j = 0; j < 16; ++j) { const unsigned c = xb_ld(&bar[XB_XCNT(j)]); sum += c; cnt += (c > 0u) ? 1u : 0u; mine = (j == x) ? c : mine; }
        if (sum == G) break;
        __builtin_amdgcn_s_sleep(1);
        if ((++sp & 255u) == 0u) { if (xb_ld(&bar[XB_TMO])) break; if (sp > XB_SPIN_CAP) { atomicAdd(&bar[XB_TMO], 1u); break; } }
    }
    nloc = mine > 0u ? mine : 1u; nx = cnt > 0u ? cnt : 1u;
}
__device__ __forceinline__ void xcd_barrier(const XcdBarrier& b) {
    asm volatile("s_waitcnt vmcnt(0)" ::: "memory");
    __syncthreads();
    if (threadIdx.x == 0) {
        unsigned* bar = b.bar;
        __builtin_amdgcn_s_waitcnt(0);
        unsigned nloc = b.st[0], nx = b.st[1];
        if (nloc == 0u) { xcd_barrier_complete(bar, b.x, nloc, nx); b.st[0] = nloc; b.st[1] = nx; }
        const unsigned old = xb_add(&bar[XB_XSUB(b.x)], 1u);
        const unsigned gen = old / nloc;
        if (old + 1u == (gen + 1u) * nloc) {
            __builtin_amdgcn_fence(__ATOMIC_RELEASE, "agent");
            asm volatile("s_waitcnt vmcnt(0)" ::: "memory");
            const unsigned og = xb_add(&bar[XB_TOP], 1u);
            const unsigned tg = og / nx;
            if (og + 1u == (tg + 1u) * nx) xb_add(&bar[XB_TOPGEN], 1u);
            else XB_SPIN(xb_ld(&bar[XB_TOPGEN]) == tg, bar);
            __builtin_amdgcn_fence(__ATOMIC_ACQUIRE, "agent");
            xb_add(&bar[XB_XGEN(b.x)], 1u);
            asm volatile("s_waitcnt vmcnt(0)" ::: "memory");
        } else {
            XB_SPIN(xb_ld(&bar[XB_XGEN(b.x)]) == gen, bar);
            __builtin_amdgcn_fence(__ATOMIC_ACQUIRE, "agent");
            asm volatile("s_waitcnt vmcnt(0)" ::: "memory");
        }
    }
    __syncthreads();
}

struct Args { const float* in[34]; float* out; unsigned char* ws; int ph_lo, ph_hi; };
static_assert(sizeof(Args) == 36 * 8 + 8, "Args has no padding");

#ifndef PHASE_MASK
#define PHASE_MASK 0x7ffff
#endif
#define IN(k) (((PHASE_MASK >> (k)) & 1) && lo <= (k) && (k) < hi)
#define SEAM(k) do { if (IN(k) && IN((k) + 1)) xcd_barrier(bar); } while (0)
#define DECL_LOCALS \
    const int tid = threadIdx.x, lane = tid & 63, wid = __builtin_amdgcn_readfirstlane(tid >> 6); \
    const int G = gridDim.x, bx = blockIdx.x; \
    const int gw = bx * 8 + wid, NGW = G * 8; \
    const int lo = a.ph_lo, hi = a.ph_hi; \
    unsigned char* ws = a.ws; \
    unsigned* ctl = (unsigned*)(ws + OFF_CTL); \
    const float* x = a.in[0]; const float* cvec = a.in[1]; const float* ctx = a.in[2]; const float* cctx = a.in[3]; \
    const float* w_ada = a.in[4]; const float* b_ada = a.in[5]; const float* n1g = a.in[6]; const float* n2g = a.in[7]; \
    const float* a_w_in = a.in[8]; const float* a_qng = a.in[9]; const float* a_w_uq = a.in[10]; const float* a_kvng = a.in[11]; \
    const float* a_w_ukv = a.in[12]; const float* a_qg = a.in[13]; const float* a_kg = a.in[14]; \
    const float* b_w_dw = a.in[15]; const float* b_b_dw = a.in[16]; const float* b_ln_g = a.in[17]; const float* b_ln_b = a.in[18]; \
    const float* ab_w_out = a.in[19]; const float* c_w_in = a.in[20]; const float* c_b_in = a.in[21]; const float* c_ln_g = a.in[22]; \
    const float* c_ln_b = a.in[23]; const float* c_w_s = a.in[24]; const float* c_b_s = a.in[25]; const float* c_w_out = a.in[26]; \
    const float* m_wg = a.in[27]; const float* m_bg = a.in[28]; const float* m_wr = a.in[29]; const float* m_br = a.in[30]; \
    const float* m_gate = a.in[31]; const float* m_up = a.in[32]; const float* m_down = a.in[33]; \
    float* xres = a.out; \
    float* mod = (float*)(ws + OFF_MOD); float* ropec = (float*)(ws + OFF_ROPE); float* ropes = ropec + 2048 * 16; \
    bf16_t* rfrag = (bf16_t*)(ws + OFF_RFRAG); float* rbias = (float*)(ws + OFF_RBIAS); \
    bf16_t* WIN_T = (bf16_t*)(ws + OFF_WIN); bf16_t* WUQ_T = (bf16_t*)(ws + OFF_WUQ); bf16_t* WUKV_T = (bf16_t*)(ws + OFF_WUKV); bf16_t* WOUT_T = (bf16_t*)(ws + OFF_WOUT); \
    bf16_t* CIN_T = (bf16_t*)(ws + OFF_CIN); bf16_t* COUT_T = (bf16_t*)(ws + OFF_COUT); bf16_t* WSB = (bf16_t*)(ws + OFF_WSB); \
    bf16_t* MGU_T = (bf16_t*)(ws + OFF_MGU); bf16_t* MDN_T = (bf16_t*)(ws + OFF_MDN); \
    int* list = (int*)(ws + OFF_LIST); float* listw = (float*)(ws + OFF_LISTW); int* tokslot = (int*)(ws + OFF_TOKSLOT); \
    bf16_t* hb = (bf16_t*)(ws + OFF_HB); bf16_t* proj = (bf16_t*)(ws + OFF_PROJ); bf16_t* qn = (bf16_t*)(ws + OFF_QN); bf16_t* kvn = (bf16_t*)(ws + OFF_KVN); bf16_t* zb = (bf16_t*)(ws + OFF_Z); \
    bf16_t* qraw = (bf16_t*)(ws + OFF_QRAW); bf16_t* kvraw = (bf16_t*)(ws + OFF_KVRAW); bf16_t* Qb = (bf16_t*)(ws + OFF_Q); bf16_t* Kb = (bf16_t*)(ws + OFF_K); bf16_t* Vb = (bf16_t*)(ws + OFF_V); \
    bf16_t* concat = (bf16_t*)(ws + OFF_CONCAT); float* krb = (float*)(ws + OFF_KR); \
    bf16_t* h2 = (bf16_t*)(ws + OFF_H2); bf16_t* actb = (bf16_t*)(ws + OFF_ACT); bf16_t* heb = (bf16_t*)(ws + OFF_HE); bf16_t* zz = (bf16_t*)(ws + OFF_ZZ); \
    (void)0;

template <int l> __device__ __forceinline__ void layer_tail(const Args& a, LAS unsigned char* lds, const XcdBarrier& bar) {
    using namespace cfg;
    DECL_LOCALS
        if (l == 1) {
            if (IN(12)) {
                pg8::Gemm g{hb, CIN_T, 1024, 1024, 1024, 0}; pg8::StaticOrder S; S.init(T, 4096, G, bx);
                pg8::EpiBf16<1> E{zz, 4096, c_b_in};
                pg8::gemm_phase<pg8::EpiBf16<1>, pg8::StaticOrder, false>(lds, g, S, E, nullptr);
            }
            SEAM(12);
            if (IN(13)) {
                LAS unsigned char* VT = lds; LAS f32x2* stat = (LAS f32x2*)(lds + 69632);
                const int g4 = lane >> 4, qq = (lane & 15) >> 2, p4 = lane & 3;
                for (int n = bx; n < 256; n += G) {
                    const size_t R0 = (size_t)n * 128;
                    for (int rr = 0; rr < 16; ++rr) { const int row = wid * 16 + rr; const bf16_t* vp = zz + (R0 + row) * 4096 + 2048 + 8 * lane;
                        float v[32];
#pragma unroll
                        for (int j = 0; j < 4; ++j) { const u32x4 w = *(const u32x4*)(vp + 512 * j);
#pragma unroll
                            for (int e = 0; e < 4; ++e) { v[8 * j + 2 * e] = bflo(w[e]); v[8 * j + 2 * e + 1] = bfhi(w[e]); } }
                        float s = 0.f;
#pragma unroll
                        for (int e = 0; e < 32; ++e) s += v[e];
                        const float mean = wave_sum(s) * (1.0f / 2048.0f); float q = 0.f;
#pragma unroll
                        for (int e = 0; e < 32; ++e) { const float d = v[e] - mean; q += d * d; }
                        const float rstd = 1.0f / sqrtf(wave_sum(q) * (1.0f / 2048.0f) + 1e-5f);
                        if (lane == 0) stat[row] = (f32x2){mean, rstd}; }
                    __syncthreads();
                    for (int g = 0; g < 8; ++g) {
                        { const int cc = tid & 31, q0 = tid >> 5;
                          const f32x4 lg0 = *(const f32x4*)(c_ln_g + 256 * g + 8 * cc), lg1 = *(const f32x4*)(c_ln_g + 256 * g + 8 * cc + 4), lb0 = *(const f32x4*)(c_ln_b + 256 * g + 8 * cc), lb1 = *(const f32x4*)(c_ln_b + 256 * g + 8 * cc + 4);
#pragma unroll
                          for (int j = 0; j < 8; ++j) { const int q = q0 + 16 * j; const u32x4 w = *(const u32x4*)(zz + (R0 + q) * 4096 + 2048 + 256 * g + 8 * cc); const f32x2 st = stat[q];
                              const f32x4 a0 = ((f32x4){bflo(w.x), bfhi(w.x), bflo(w.y), bfhi(w.y)} - st.x) * st.y * lg0 + lb0, a1 = ((f32x4){bflo(w.z), bfhi(w.z), bflo(w.w), bfhi(w.w)} - st.x) * st.y * lg1 + lb1;
                              *(LAS u32x4*)(VT + q * 544 + cc * 16) = (u32x4){pk2(a0.x, a0.y), pk2(a0.z, a0.w), pk2(a1.x, a1.y), pk2(a1.z, a1.w)}; } }
                        __syncthreads();
                        f32x4 acc[2][8];
#pragma unroll
                        for (int mb = 0; mb < 2; ++mb)
#pragma unroll
                            for (int nb = 0; nb < 8; ++nb) acc[mb][nb] = (f32x4){0.f, 0.f, 0.f, 0.f};
#pragma unroll
                        for (int kb = 0; kb < 4; ++kb) {
                            bf16x8 af[2];
#pragma unroll
                            for (int mb = 0; mb < 2; ++mb) { const LAS unsigned char* ap = VT + (32 * kb + 8 * g4 + qq) * 544 + (32 * wid + 16 * mb) * 2 + 8 * p4;
                                const att::s16x4 t0 = __builtin_bit_cast(att::s16x4, __builtin_amdgcn_ds_read_tr16_b64_v4i16((LAS att::s16x4*)(ap)));
                                const att::s16x4 t1 = __builtin_bit_cast(att::s16x4, __builtin_amdgcn_ds_read_tr16_b64_v4i16((LAS att::s16x4*)(ap + 4 * 544)));
                                af[mb] = (bf16x8){t0[0], t0[1], t0[2], t0[3], t1[0], t1[1], t1[2], t1[3]}; }
#pragma unroll
                            for (int nb = 0; nb < 8; ++nb) { const bf16x8 bfr = *(const bf16x8*)(WSB + ((size_t)(g * 128 + 16 * nb + (lane & 15))) * 128 + 32 * kb + 8 * g4);
#pragma unroll
                                for (int mb = 0; mb < 2; ++mb) acc[mb][nb] = __builtin_amdgcn_mfma_f32_16x16x32_bf16(af[mb], bfr, acc[mb][nb], 0, 0, 0); }
                        }
#pragma unroll
                        for (int nb = 0; nb < 8; ++nb) { const int p = 16 * nb + (lane & 15); const float bs = c_b_s[g * 128 + p];
#pragma unroll
                            for (int mb = 0; mb < 2; ++mb) { bf16_t* up = zz + (R0 + p) * 4096 + 256 * g + 32 * wid + 16 * mb + 4 * g4; const u32x2 uw = *(const u32x2*)up;
                                u32x2 o; o.x = pk2(bflo(uw.x) * (acc[mb][nb][0] + bs), bfhi(uw.x) * (acc[mb][nb][1] + bs)); o.y = pk2(bflo(uw.y) * (acc[mb][nb][2] + bs), bfhi(uw.y) * (acc[mb][nb][3] + bs));
                                *(u32x2*)up = o; } }
                        __syncthreads();
                    }
                }
            }
            SEAM(13);
            if (IN(14)) {
                pg8::Gemm g{zz, COUT_T, 4096, 2048, 2048, 0}; pg8::StaticOrder S; S.init(T, 1024, G, bx);
                pg8::EpiResid E{xres, xres, mod + (size_t)17 * 6144 + 2048, 6144};
                pg8::gemm_phase<pg8::EpiResid, pg8::StaticOrder, false>(lds, g, S, E, nullptr);
            }
            SEAM(14);
        }
        const int pb = l ? 15 : 8;
        const float* modl = mod + (size_t)l * 17 * 6144;
        unsigned* gcnt = ctl + CW_GCNT + l * 32 * 64;
        LAS int* tb = (LAS int*)(lds + LDS_TB); LAS int* cntl = (LAS int*)(lds + LDS_CNT);
        if (IN(pb)) {
            LAS float* lg = (LAS float*)lds + wid * 768;
            LAS int* hist = (LAS int*)(lds + 32768); LAS int* hist2 = hist + 32; LAS int* basel = hist + 64; LAS int* re = hist + 128; LAS float* rw = (LAS float*)(hist + 128 + 256);
            const float* gn = n2g + l * 1024; const bf16_t* rf = rfrag + (size_t)l * 32 * 3 * 2 * 512;
            const int r16 = lane & 15, kg = lane >> 4;
            for (int blk = bx; blk < 256; blk += G) {
                if (tid < 64) hist[tid] = 0;
                const int t0 = blk * 128 + wid * 16, tok = t0 + r16; const float* md = modl + (size_t)(t0 >> 11) * 6144;
                const float* xr = xres + (size_t)tok * 1024 + 8 * kg;
                float ss = 0.f;
                for (int kb = 0; kb < 32; ++kb) { const f32x4 v0 = *(const f32x4*)(xr + 32 * kb), v1 = *(const f32x4*)(xr + 32 * kb + 4);
                    ss += (v0.x * v0.x + v0.y * v0.y) + (v0.z * v0.z + v0.w * v0.w) + (v1.x * v1.x + v1.y * v1.y) + (v1.z * v1.z + v1.w * v1.w); }
                ss += __shfl_xor(ss, 16); ss += __shfl_xor(ss, 32);
                const float rstd = 1.0f / sqrtf(ss * (1.0f / 1024.0f) + 1e-6f);
                f32x4 acc[3];
#pragma unroll
                for (int cb = 0; cb < 3; ++cb) acc[cb] = (f32x4){0.f, 0.f, 0.f, 0.f};
                for (int kb = 0; kb < 32; ++kb) { const int c = 32 * kb + 8 * kg;
                    const f32x4 v0 = *(const f32x4*)(xr + 32 * kb), v1 = *(const f32x4*)(xr + 32 * kb + 4);
                    const f32x4 y0 = v0 * rstd * *(const f32x4*)(gn + c) * (*(const f32x4*)(md + 4096 + c) + 1.0f) + *(const f32x4*)(md + 3072 + c);
                    const f32x4 y1 = v1 * rstd * *(const f32x4*)(gn + c + 4) * (*(const f32x4*)(md + 4096 + c + 4) + 1.0f) + *(const f32x4*)(md + 3072 + c + 4);
                    const u32x4 hw = (u32x4){pk2(y0.x, y0.y), pk2(y0.z, y0.w), pk2(y1.x, y1.y), pk2(y1.z, y1.w)};
                    *(u32x4*)(h2 + (size_t)tok * 1024 + c) = hw;
                    const u32x4 lw = (u32x4){pk2(y0.x - bflo(hw.x), y0.y - bfhi(hw.x)), pk2(y0.z - bflo(hw.y), y0.w - bfhi(hw.y)), pk2(y1.x - bflo(hw.z), y1.y - bfhi(hw.z)), pk2(y1.z - bflo(hw.w), y1.w - bfhi(hw.w))};
                    const bf16x8 Hh = __builtin_bit_cast(bf16x8, hw), Hl = __builtin_bit_cast(bf16x8, lw);
#pragma unroll
                    for (int cb = 0; cb < 3; ++cb) { const bf16x8 Wh = *(const bf16x8*)(rf + ((size_t)((kb * 3 + cb) * 2 + 0) * 64 + lane) * 8), Wl = *(const bf16x8*)(rf + ((size_t)((kb * 3 + cb) * 2 + 1) * 64 + lane) * 8);
                        acc[cb] = __builtin_amdgcn_mfma_f32_16x16x32_bf16(Wh, Hh, acc[cb], 0, 0, 0);
                        acc[cb] = __builtin_amdgcn_mfma_f32_16x16x32_bf16(Wh, Hl, acc[cb], 0, 0, 0);
                        acc[cb] = __builtin_amdgcn_mfma_f32_16x16x32_bf16(Wl, Hh, acc[cb], 0, 0, 0); }
                }
#pragma unroll
                for (int cb = 0; cb < 3; ++cb)
#pragma unroll
                    for (int e = 0; e < 4; ++e) lg[r16 * 48 + 16 * cb + 4 * kg + e] = acc[cb][e] + rbias[l * 48 + 16 * cb + 4 * kg + e];
                __syncthreads();
                int e0 = 0, e1 = 0; float w0 = 0.f, w1 = 0.f;
                if (lane < 16) {
                    const LAS float* L = lg + lane * 48;
                    int gi = 0; float gm = L[32];
#pragma unroll
                    for (int g = 1; g < 4; ++g) { const float v = L[32 + g]; if (v > gm) { gm = v; gi = g; } }
                    float gs = 0.f;
#pragma unroll
                    for (int g = 0; g < 4; ++g) gs += expf(L[32 + g] - gm);
                    const float gwt = 1.0f / gs;
                    float v0 = -1e30f, v1 = -1e30f; int i0 = 0, i1 = 0;
#pragma unroll
                    for (int e = 0; e < 8; ++e) { const float v = L[gi * 8 + e]; if (v > v0) { v1 = v0; i1 = i0; v0 = v; i0 = e; } else if (v > v1) { v1 = v; i1 = e; } }
                    const float ex = expf(v1 - v0); w0 = gwt / (1.0f + ex); w1 = gwt * ex / (1.0f + ex);
                    e0 = gi * 8 + i0; e1 = gi * 8 + i1;
                    __hip_atomic_fetch_add(&hist[e0], 1, __ATOMIC_RELAXED, __HIP_MEMORY_SCOPE_WORKGROUP); __hip_atomic_fetch_add(&hist[e1], 1, __ATOMIC_RELAXED, __HIP_MEMORY_SCOPE_WORKGROUP);
                }
                __syncthreads();
                if (tid < 32) basel[tid] = (int)atomicAdd(gcnt + tid * 64, (unsigned)hist[tid]);
                __syncthreads();
                if (lane < 16) {
                    const int p0 = basel[e0] + __hip_atomic_fetch_add(&hist2[e0], 1, __ATOMIC_RELAXED, __HIP_MEMORY_SCOPE_WORKGROUP), p1 = basel[e1] + __hip_atomic_fetch_add(&hist2[e1], 1, __ATOMIC_RELAXED, __HIP_MEMORY_SCOPE_WORKGROUP);
                    list[e0 * 32768 + p0] = tok; listw[e0 * 32768 + p0] = w0; list[e1 * 32768 + p1] = tok; listw[e1 * 32768 + p1] = w1;
                    tokslot[tok * 2] = e0 * 32768 + p0; tokslot[tok * 2 + 1] = e1 * 32768 + p1;
                }
                __syncthreads();
            }
        }
        SEAM(pb);
        if (IN(pb + 1) || IN(pb + 2) || IN(pb + 3)) {
            __syncthreads();
            if (tid == 0) { int accn = 0; for (int e = 0; e < 32; ++e) { const int c = (int)__hip_atomic_load(gcnt + e * 64, __ATOMIC_RELAXED, __HIP_MEMORY_SCOPE_AGENT); cntl[e] = c; tb[e] = accn; accn += (c + 255) >> 8; } tb[32] = accn; }
            __syncthreads();
        }
        if (IN(pb + 1)) {
            LAS int* tokl = (LAS int*)(lds + LDS_TOKL); LAS float* wl = (LAS float*)(lds + LDS_WL);
            volatile LAS int* ut = (volatile LAS int*)(lds + LDS_UT);
            if (tid == 0) pg8::build_units(ut, tb, 2, G, bx);
            __syncthreads();
            pg8::GroupedOrder S{ut, __builtin_amdgcn_readfirstlane(ut[32])};
            { pg8::Unit u; for (int ui = 0; ui < 4 && S.next(ui, u); ++ui) if (tid < 256) { const int pos = u.aux * 256 + tid; const bool ok = pos < cntl[u.eb];
                  tokl[ui * 256 + tid] = ok ? list[u.eb * 32768 + pos] : 0; wl[ui * 256 + tid] = ok ? listw[u.eb * 32768 + pos] : 0.f; } }
            __syncthreads();
            pg8::Gemm g{h2, MGU_T + (size_t)l * 32 * 512 * 1024, 1024, 1024, 1024, (size_t)512 * 1024};
            pg8::EpiAct E{actb, wl};
            pg8::gemm_phase<pg8::EpiAct, pg8::GroupedOrder, true>(lds, g, S, E, tokl);
        }
        SEAM(pb + 1);
        if (IN(pb + 2)) {
            volatile LAS int* ut = (volatile LAS int*)(lds + LDS_UT);
            if (tid == 0) pg8::build_units(ut, tb, 4, G, bx);
            __syncthreads();
            pg8::GroupedOrder S{ut, __builtin_amdgcn_readfirstlane(ut[32])};
            pg8::Gemm g{actb, MDN_T + (size_t)l * 32 * 1024 * 256, 256, 256, 256, (size_t)1024 * 256};
            pg8::EpiBf16<0> E{heb, 1024, nullptr};
            pg8::gemm_phase<pg8::EpiBf16<0>, pg8::GroupedOrder, false>(lds, g, S, E, nullptr);
        }
        SEAM(pb + 2);
        if (IN(pb + 3)) {
            for (int tok = gw; tok < T; tok += NGW) {
                const int s0 = tokslot[tok * 2], s1 = tokslot[tok * 2 + 1];
                const size_t r0 = (size_t)tb[s0 >> 15] * 256 + (s0 & 32767), r1 = (size_t)tb[s1 >> 15] * 256 + (s1 & 32767);
                const int b = tok >> 11; const float* g2 = modl + (size_t)b * 6144 + 5120;
                f32x4 y[4]; float ss = 0.f;
#pragma unroll
                for (int j = 0; j < 4; ++j) { const int c = 4 * lane + 256 * j; const f32x4 xv = *(const f32x4*)(xres + (size_t)tok * 1024 + c);
                    const u32x2 h0 = *(const u32x2*)(heb + r0 * 1024 + c), h1 = *(const u32x2*)(heb + r1 * 1024 + c);
                    const f32x4 m = (f32x4){bflo(h0.x) + bflo(h1.x), bfhi(h0.x) + bfhi(h1.x), bflo(h0.y) + bflo(h1.y), bfhi(h0.y) + bfhi(h1.y)};
                    y[j] = xv + *(const f32x4*)(g2 + c) * m; *(f32x4*)(xres + (size_t)tok * 1024 + c) = y[j];
                    ss += (y[j].x * y[j].x + y[j].y * y[j].y) + (y[j].z * y[j].z + y[j].w * y[j].w); }
                if (l == 0) {
                    const float rstd = 1.0f / sqrtf(wave_sum(ss) * (1.0f / 1024.0f) + 1e-6f);
                    const float* m1 = mod + (size_t)(17 + b) * 6144;
#pragma unroll
                    for (int j = 0; j < 4; ++j) { const int c = 4 * lane + 256 * j;
                        const f32x4 o = y[j] * rstd * *(const f32x4*)(n1g + 1024 + c) * (*(const f32x4*)(m1 + 1024 + c) + 1.0f) + *(const f32x4*)(m1 + c);
                        u32x2 ow; ow.x = pk2(o.x, o.y); ow.y = pk2(o.z, o.w); *(u32x2*)(hb + (size_t)tok * 1024 + c) = ow; }
                }
            }
        }
        if (l == 0) SEAM(11);
}

__global__ void __launch_bounds__(512, 2) fwd(Args a) {
    using namespace cfg;
    extern __shared__ __attribute__((aligned(16))) unsigned char lds_raw[];
    LAS unsigned char* lds = (LAS unsigned char*)lds_raw;
    DECL_LOCALS
    volatile LAS unsigned* MISC = (volatile LAS unsigned*)(lds + LDS_MISC);
    if (tid < 16) MISC[tid] = 0u;
    __syncthreads();
    XcdBarrier bar; bar.bar = ctl + CW_BAR; bar.x = 0; bar.st = nullptr;
    const bool multi = (hi - lo) > 1;
    if (multi) bar = xcd_barrier_post(ctl + CW_BAR, MISC + 8);

    if (IN(0)) {
        if (bx < 192) {
            const int l = bx / 96, jb = bx % 96;
            LAS float* sl = (LAS float*)lds; LAS float* part = (LAS float*)(lds + 69632);
            for (int i = tid; i < 17 * 1024; i += 512) { const int r = i >> 10, k = i & 1023; const float v = (r < 16) ? cvec[r * 1024 + k] : cctx[k]; sl[i] = v / (1.0f + expf(-v)); }
            __syncthreads();
            float acc[17];
#pragma unroll
            for (int r = 0; r < 17; ++r) acc[r] = 0.f;
            const float* wp = w_ada + (size_t)l * 1024 * 6144 + jb * 64 + lane;
            for (int k = wid * 128; k < wid * 128 + 128; ++k) { const float w = wp[(size_t)k * 6144];
#pragma unroll
                for (int r = 0; r < 17; ++r) acc[r] += sl[r * 1024 + k] * w; }
#pragma unroll
            for (int r = 0; r < 17; ++r) part[(wid * 17 + r) * 64 + lane] = acc[r];
            __syncthreads();
            for (int i = tid; i < 17 * 64; i += 512) { const int r = i >> 6, j = i & 63; float s = 0.f;
#pragma unroll
                for (int q = 0; q < 8; ++q) s += part[(q * 17 + r) * 64 + j];
                mod[((size_t)l * 17 + r) * 6144 + jb * 64 + j] = s + b_ada[l * 6144 + jb * 64 + j]; }
            __syncthreads();
        }
        {
            LAS float* scr = (LAS float*)(lds + wid * 16384);
            constexpr int I_WIN = 16 * 53, I_UQ = 6 * 24, I_UKV = 4 * 32, I_OUT = 16 * 32, I_CIN = 16 * 128, I_COUT = 32 * 32, I_MOE = 64 * 384;
            constexpr int NITEMS = I_WIN + I_UQ + I_UKV + I_OUT + I_CIN + I_COUT + I_MOE;
            for (int it = gw; it < NITEMS; it += NGW) {
                int r = it;
                if (r < I_WIN) { transpose_item(a_w_in, 1696, 64 * (r / 53), 32 * (r % 53), WIN_T, 1024, 32 * (r % 53), nullptr, scr, lane); continue; } r -= I_WIN;
                if (r < I_UQ) { transpose_item(a_w_uq, 768, 64 * (r / 24), 32 * (r % 24), WUQ_T, 384, 32 * (r % 24), a_qng, scr, lane); continue; } r -= I_UQ;
                if (r < I_UKV) { transpose_item(a_w_ukv, 1024, 64 * (r / 32), 32 * (r % 32), WUKV_T, 256, 32 * (r % 32), a_kvng, scr, lane); continue; } r -= I_UKV;
                if (r < I_OUT) { transpose_item(ab_w_out, 1024, 64 * (r / 32), 32 * (r % 32), WOUT_T, 1024, 32 * (r % 32), nullptr, scr, lane); continue; } r -= I_OUT;
                if (r < I_CIN) { transpose_item(c_w_in, 4096, 64 * (r / 128), 32 * (r % 128), CIN_T, 1024, 32 * (r % 128), nullptr, scr, lane); continue; } r -= I_CIN;
                if (r < I_COUT) { transpose_item(c_w_out, 1024, 64 * (r / 32), 32 * (r % 32), COUT_T, 2048, 32 * (r % 32), nullptr, scr, lane); continue; } r -= I_COUT;
                const int le = r / 384, q = r % 384;
                if (q < 128) { const int n0 = 32 * (q % 8); transpose_item(m_gate + (size_t)le * 1024 * 256, 256, 64 * (q / 8), n0, MGU_T + (size_t)le * 512 * 1024, 1024, (n0 >> 7) * 256 + (n0 & 127), nullptr, scr, lane); }
                else if (q < 256) { const int q2 = q - 128, n0 = 32 * (q2 % 8); transpose_item(m_up + (size_t)le * 1024 * 256, 256, 64 * (q2 / 8), n0, MGU_T + (size_t)le * 512 * 1024, 1024, (n0 >> 7) * 256 + 128 + (n0 & 127), nullptr, scr, lane); }
                else { const int q2 = q - 256; transpose_item(m_down + (size_t)le * 256 * 1024, 1024, 64 * (q2 / 32), 32 * (q2 % 32), MDN_T + (size_t)le * 1024 * 256, 256, 32 * (q2 % 32), nullptr, scr, lane); }
            }
        }
        {
            const int gt = bx * 512 + tid, NGT = G * 512;
            for (int i = gt; i < 96 * 128; i += NGT) *(u32x4*)(WIN_T + (size_t)1696 * 1024 + (size_t)i * 8) = (u32x4){0u, 0u, 0u, 0u};
            for (int i = gt; i < 8 * 128 * 128 / 8; i += NGT) { const f32x4 v0 = *(const f32x4*)(c_w_s + (size_t)i * 8), v1 = *(const f32x4*)(c_w_s + (size_t)i * 8 + 4);
                *(u32x4*)(WSB + (size_t)i * 8) = (u32x4){pk2(v0.x, v0.y), pk2(v0.z, v0.w), pk2(v1.x, v1.y), pk2(v1.z, v1.w)}; }
            for (int i = gt; i < 2048 * 16; i += NGT) { const int pos = i >> 4, j = i & 15; const float p = (j < 8) ? (float)(pos >> 6) : (float)(pos & 63);
                const float ang = p * powf(10000.f, -(float)(j & 7) / 8.f); ropec[i] = cosf(ang); ropes[i] = sinf(ang); }
            for (int i = gt; i < 2 * 32 * 3 * 2 * 64; i += NGT) {
                const int ln = i & 63, hl = (i >> 6) & 1, rest = i >> 7, cb = rest % 3, kb = (rest / 3) % 32, l = rest / 96;
                const int o = 16 * cb + (ln & 15), d0 = 32 * kb + 8 * (ln >> 4); unsigned w[4];
#pragma unroll
                for (int jj = 0; jj < 4; ++jj) { float v[2];
#pragma unroll
                    for (int e = 0; e < 2; ++e) { const int d = d0 + 2 * jj + e; float f = 0.f;
                        if (o < 32) f = m_wr[(((size_t)l * 4 + (o >> 3)) * 1024 + d) * 8 + (o & 7)]; else if (o < 36) f = m_wg[((size_t)l * 1024 + d) * 4 + (o - 32)];
                        const float fh = __uint_as_float(pk2(f, 0.f) << 16); v[e] = hl ? (f - fh) : f; }
                    w[jj] = pk2(v[0], v[1]); }
                *(u32x4*)(rfrag + (size_t)i * 8) = (u32x4){w[0], w[1], w[2], w[3]}; }
            for (int i = gt; i < 2 * 48; i += NGT) { const int l = i / 48, o = i % 48; rbias[i] = (o < 32) ? m_br[l * 32 + o] : (o < 36 ? m_bg[l * 4 + o - 32] : 0.f); }
        }
    }
    SEAM(0);
    if (IN(1)) {
        for (int row = gw; row < TA; row += NGW) {
            const float* src; const float* md;
            if (row < T) { src = x + (size_t)row * 1024; md = mod + (size_t)(row >> 11) * 6144; } else { src = ctx + (size_t)(row - T) * 1024; md = mod + (size_t)16 * 6144; }
            norm_mod_row(src, n1g, md, md + 1024, hb + (size_t)row * 1024, lane);
        }
    }
    SEAM(1);
    if (IN(2)) {
        pg8::Gemm g{hb, WIN_T, 1024, 1024, 1024, 0}; pg8::StaticOrder S; S.init(TA, AINP, G, bx);
        pg8::EpiBf16<0> E{proj, AINP, nullptr};
        pg8::gemm_phase<pg8::EpiBf16<0>, pg8::StaticOrder, false>(lds, g, S, E, nullptr);
    }
    SEAM(2);
    if (IN(3)) {
        for (int row = gw; row < TA; row += NGW) {
            const bf16_t* pr = proj + (size_t)row * AINP;
            { const u32x2 w = *(const u32x2*)(pr + 384 + 4 * lane); const float v0 = bflo(w.x), v1 = bfhi(w.x), v2 = bflo(w.y), v3 = bfhi(w.y);
              const float rstd = 1.0f / sqrtf(wave_sum((v0 * v0 + v1 * v1) + (v2 * v2 + v3 * v3)) * (1.0f / 256.0f) + 1e-6f);
              u32x2 o; o.x = pk2(v0 * rstd, v1 * rstd); o.y = pk2(v2 * rstd, v3 * rstd); *(u32x2*)(kvn + (size_t)row * 256 + 4 * lane) = o; }
            if (lane < 32) krb[(size_t)row * 32 + lane] = bf2f(pr[640 + lane]);
            if (row < T) {
                const unsigned* pq = (const unsigned*)(pr + 6 * lane); const unsigned w0 = pq[0], w1 = pq[1], w2 = pq[2];
                const float q0 = bflo(w0), q1 = bfhi(w0), q2 = bflo(w1), q3 = bfhi(w1), q4 = bflo(w2), q5 = bfhi(w2);
                const float rstd = 1.0f / sqrtf(wave_sum((q0 * q0 + q1 * q1) + (q2 * q2 + q3 * q3) + (q4 * q4 + q5 * q5)) * (1.0f / 384.0f) + 1e-6f);
                unsigned* oq = (unsigned*)(qn + (size_t)row * 384 + 6 * lane); oq[0] = pk2(q0 * rstd, q1 * rstd); oq[1] = pk2(q2 * rstd, q3 * rstd); oq[2] = pk2(q4 * rstd, q5 * rstd);
                const u32x4 av = *(const u32x4*)(pr + 672 + 8 * lane), bv = *(const u32x4*)(pr + 1184 + 8 * lane); u32x4 zo;
#pragma unroll
                for (int j = 0; j < 4; ++j) zo[j] = pk2(bflo(av[j]) * sigmoid_fast(bflo(bv[j])), bfhi(av[j]) * sigmoid_fast(bfhi(bv[j])));
                *(u32x4*)(zb + (size_t)row * 512 + 8 * lane) = zo;
            }
        }
    }
    SEAM(3);
    if (IN(4)) {
        { pg8::Gemm g{qn, WUQ_T, 384, 384, 384, 0}; pg8::StaticOrder S; S.init(T, 768, G, bx); pg8::EpiBf16<0> E{qraw, 768, nullptr};
          pg8::gemm_phase<pg8::EpiBf16<0>, pg8::StaticOrder, false>(lds, g, S, E, nullptr); }
        { pg8::Gemm g{kvn, WUKV_T, 256, 256, 256, 0}; pg8::StaticOrder S; S.init(TA, 1024, G, bx); pg8::EpiBf16<0> E{kvraw, 1024, nullptr};
          pg8::gemm_phase<pg8::EpiBf16<0>, pg8::StaticOrder, false>(lds, g, S, E, nullptr); }
        __syncthreads();
        LAS unsigned char* zin = lds; LAS float* cvo = (LAS float*)(lds + 63488);
        float wd[31];
#pragma unroll
        for (int w = 0; w < 31; ++w) wd[w] = b_w_dw[w * 512 + tid];
        const float cbias = b_b_dw[tid];
        for (int u = bx; u < 1024; u += G) {
            const int b = u >> 6, t0 = (u & 63) * 32;
            for (int idx = tid; idx < 62 * 64; idx += 512) { const int i = idx >> 6, c16 = idx & 63, tt = t0 - 15 + i;
                u32x4 v = (u32x4){0u, 0u, 0u, 0u}; if (tt >= 0 && tt < 2048) v = *(const u32x4*)(zb + ((size_t)(b * 2048 + tt)) * 512 + c16 * 8);
                *(LAS u32x4*)(zin + i * 1024 + c16 * 16) = v; }
            __syncthreads();
            float acc[32];
#pragma unroll
            for (int t = 0; t < 32; ++t) acc[t] = 0.f;
#pragma unroll
            for (int i = 0; i < 62; ++i) { const float zi = bf2f(*(const LAS unsigned short*)(zin + i * 1024 + tid * 2));
#pragma unroll
                for (int t = 0; t < 32; ++t) if (i - t >= 0 && i - t <= 30) acc[t] += zi * wd[i - t]; }
#pragma unroll
            for (int t = 0; t < 32; ++t) cvo[t * 512 + tid] = acc[t] + cbias;
            __syncthreads();
#pragma unroll
            for (int k = 0; k < 4; ++k) { const int t = wid * 4 + k; const f32x4 v0 = *(const LAS f32x4*)(cvo + t * 512 + 8 * lane), v1 = *(const LAS f32x4*)(cvo + t * 512 + 8 * lane + 4);
                const float mean = wave_sum((v0.x + v0.y) + (v0.z + v0.w) + (v1.x + v1.y) + (v1.z + v1.w)) * (1.0f / 512.0f);
                const f32x4 d0 = v0 - mean, d1 = v1 - mean;
                const float var = wave_sum((d0.x * d0.x + d0.y * d0.y) + (d0.z * d0.z + d0.w * d0.w) + (d1.x * d1.x + d1.y * d1.y) + (d1.z * d1.z + d1.w * d1.w)) * (1.0f / 512.0f);
                const float rstd = 1.0f / sqrtf(var + 1e-5f);
                const f32x4 g0 = *(const f32x4*)(b_ln_g + 8 * lane), g1 = *(const f32x4*)(b_ln_g + 8 * lane + 4), e0 = *(const f32x4*)(b_ln_b + 8 * lane), e1 = *(const f32x4*)(b_ln_b + 8 * lane + 4);
                const f32x4 y0 = d0 * rstd * g0 + e0, y1 = d1 * rstd * g1 + e1;
                u32x4 o; o.x = pk2(silu_fast(y0.x), silu_fast(y0.y)); o.y = pk2(silu_fast(y0.z), silu_fast(y0.w)); o.z = pk2(silu_fast(y1.x), silu_fast(y1.y)); o.w = pk2(silu_fast(y1.z), silu_fast(y1.w));
                *(u32x4*)(concat + ((size_t)(b * 2048 + t0 + t)) * 1024 + 512 + 8 * lane) = o; }
            __syncthreads();
        }
    }
    SEAM(4);
    if (IN(5)) {
        const int h = lane >> 3, l8 = lane & 7;
        const f32x4 kg0 = *(const f32x4*)(a_kg + 8 * l8), kg1 = *(const f32x4*)(a_kg + 8 * l8 + 4), qg0 = *(const f32x4*)(a_qg + 8 * l8), qg1 = *(const f32x4*)(a_qg + 8 * l8 + 4);
        const f32x2 kgr1 = *(const f32x2*)(a_kg + 64 + 2 * l8), kgr2 = *(const f32x2*)(a_kg + 80 + 2 * l8), qgr1 = *(const f32x2*)(a_qg + 64 + 2 * l8), qgr2 = *(const f32x2*)(a_qg + 80 + 2 * l8);
        for (int row = gw; row < TA; row += NGW) {
            int b, key, pos; bool rope;
            if (row < T) { b = row >> 11; pos = row & 2047; key = 256 + pos; rope = true; } else { const int rc = row - T; b = rc >> 8; key = rc & 255; pos = 0; rope = false; }
            const int bh = b * 8 + h;
            f32x2 cs = (f32x2){1.f, 1.f}, sn = (f32x2){0.f, 0.f};
            if (rope) { cs = *(const f32x2*)(ropec + pos * 16 + 2 * l8); sn = *(const f32x2*)(ropes + pos * 16 + 2 * l8); }
            {
                const u32x4 kw = *(const u32x4*)(kvraw + (size_t)row * 1024 + h * 128 + 8 * l8);
                const f32x2 x1 = *(const f32x2*)(krb + (size_t)row * 32 + 2 * l8), x2 = *(const f32x2*)(krb + (size_t)row * 32 + 16 + 2 * l8);
                float v[8];
#pragma unroll
                for (int j = 0; j < 4; ++j) { v[2 * j] = bflo(kw[j]); v[2 * j + 1] = bfhi(kw[j]); }
                float ss = (x1.x * x1.x + x1.y * x1.y) + (x2.x * x2.x + x2.y * x2.y);
#pragma unroll
                for (int j = 0; j < 8; ++j) ss += v[j] * v[j];
                ss += __shfl_xor(ss, 1); ss += __shfl_xor(ss, 2); ss += __shfl_xor(ss, 4);
                const float rstd = 1.0f / sqrtf(ss * (1.0f / 96.0f) + 1e-6f);
                bf16_t* ko = Kb + ((size_t)bh * NK + key) * 96;
                u32x4 o; o.x = pk2(v[0] * rstd * kg0.x, v[1] * rstd * kg0.y); o.y = pk2(v[2] * rstd * kg0.z, v[3] * rstd * kg0.w); o.z = pk2(v[4] * rstd * kg1.x, v[5] * rstd * kg1.y); o.w = pk2(v[6] * rstd * kg1.z, v[7] * rstd * kg1.w);
                *(u32x4*)(ko + 8 * l8) = o;
                const f32x2 a1 = x1 * rstd * kgr1, a2 = x2 * rstd * kgr2;
                const f32x2 o1 = a1 * cs - a2 * sn, o2 = a1 * sn + a2 * cs;
                *(unsigned*)(ko + 64 + 2 * l8) = pk2(o1.x, o1.y); *(unsigned*)(ko + 80 + 2 * l8) = pk2(o2.x, o2.y);
                *(u32x4*)(Vb + ((size_t)bh * NK + key) * 64 + 8 * l8) = *(const u32x4*)(kvraw + (size_t)row * 1024 + h * 128 + 64 + 8 * l8);
            }
            if (row < T) {
                const bf16_t* qp = qraw + (size_t)row * 768 + h * 96;
                const u32x4 qw = *(const u32x4*)(qp + 8 * l8); const unsigned r1 = *(const unsigned*)(qp + 64 + 2 * l8), r2 = *(const unsigned*)(qp + 80 + 2 * l8);
                float v[8];
#pragma unroll
                for (int j = 0; j < 4; ++j) { v[2 * j] = bflo(qw[j]); v[2 * j + 1] = bfhi(qw[j]); }
                const f32x2 x1 = (f32x2){bflo(r1), bfhi(r1)}, x2 = (f32x2){bflo(r2), bfhi(r2)};
                float ss = (x1.x * x1.x + x1.y * x1.y) + (x2.x * x2.x + x2.y * x2.y);
#pragma unroll
                for (int j = 0; j < 8; ++j) ss += v[j] * v[j];
                ss += __shfl_xor(ss, 1); ss += __shfl_xor(ss, 2); ss += __shfl_xor(ss, 4);
                const float rstd = QSCALE / sqrtf(ss * (1.0f / 96.0f) + 1e-6f);
                bf16_t* qo = Qb + ((size_t)bh * 2048 + pos) * 96;
                u32x4 o; o.x = pk2(v[0] * rstd * qg0.x, v[1] * rstd * qg0.y); o.y = pk2(v[2] * rstd * qg0.z, v[3] * rstd * qg0.w); o.z = pk2(v[4] * rstd * qg1.x, v[5] * rstd * qg1.y); o.w = pk2(v[6] * rstd * qg1.z, v[7] * rstd * qg1.w);
                *(u32x4*)(qo + 8 * l8) = o;
                const f32x2 a1 = x1 * rstd * qgr1, a2 = x2 * rstd * qgr2;
                const f32x2 o1 = a1 * cs - a2 * sn, o2 = a1 * sn + a2 * cs;
                *(unsigned*)(qo + 64 + 2 * l8) = pk2(o1.x, o1.y); *(unsigned*)(qo + 80 + 2 * l8) = pk2(o2.x, o2.y);
            }
        }
    }
    SEAM(5);
    if (IN(6)) {
        const int vcu = (G % 8 == 0) ? (bx % 8) * (G / 8) + bx / 8 : bx;
        for (int U = vcu; U < 1024; U += G) att::attn_unit(U >> 3, U & 7, Qb, Kb, Vb, concat, lds);
        asm volatile("s_waitcnt vmcnt(0) lgkmcnt(0)\n\ts_barrier" ::: "memory");
    }
    SEAM(6);
    if (IN(7)) {
        pg8::Gemm g{concat, WOUT_T, 1024, 1024, 1024, 0}; pg8::StaticOrder S; S.init(T, 1024, G, bx);
        pg8::EpiResid E{x, xres, mod + 2048, 6144};
        pg8::gemm_phase<pg8::EpiResid, pg8::StaticOrder, false>(lds, g, S, E, nullptr);
    }
    SEAM(7);

    layer_tail<0>(a, lds, bar);
    layer_tail<1>(a, lds, bar);
}
#undef IN
#undef SEAM

extern "C" void kernel_launch(void* const* d_in, const int* in_sizes, int n_in, void* d_out, int out_size, void* d_ws, size_t ws_size, hipStream_t stream) {
    using namespace cfg;
    static int grid = 0;
    if (grid == 0) {
        if (n_in != 34 || out_size != T * D || ws_size < WS_NEED) { fprintf(stderr, "kernel_launch: unexpected problem shape or workspace (%d inputs, out %d, ws %zu)\n", n_in, out_size, ws_size); grid = -1; return; }
        int dev = 0, cus = 0, per_cu = 0;
        if (hipGetDevice(&dev) != hipSuccess || hipDeviceGetAttribute(&cus, hipDeviceAttributeMultiprocessorCount, dev) != hipSuccess) { grid = -1; return; }
        if (hipFuncSetAttribute((const void*)fwd, hipFuncAttributeMaxDynamicSharedMemorySize, LDS_BYTES) != hipSuccess) { fprintf(stderr, "kernel_launch: hipFuncSetAttribute failed\n"); grid = -1; return; }
        if (hipOccupancyMaxActiveBlocksPerMultiprocessor(&per_cu, (const void*)fwd, 512, LDS_BYTES) != hipSuccess || per_cu < 1) { fprintf(stderr, "kernel_launch: occupancy query reports %d\n", per_cu); }
        (void)hipGetLastError();
        grid = cus;
    }
    if (grid < 0) return;
    (void)hipMemsetAsync((char*)d_ws + OFF_CTL, 0, CTL_BYTES, stream);
    Args a{};
    for (int i = 0; i < 34; ++i) a.in[i] = (const float*)d_in[i];
    a.out = (float*)d_out; a.ws = (unsigned char*)d_ws;
#ifndef MK_ONE_LAUNCH
#define MK_ONE_LAUNCH 0
#endif
    if (MK_ONE_LAUNCH) { a.ph_lo = 0; a.ph_hi = NPHASE; hipLaunchKernelGGL(fwd, dim3(grid), dim3(512), LDS_BYTES, stream, a); }
    else for (int p = 0; p < NPHASE; ++p) { a.ph_lo = p; a.ph_hi = p + 1; hipLaunchKernelGGL(fwd, dim3(grid), dim3(512), LDS_BYTES, stream, a); }
}
```

```cpp
#define MK_ONE_LAUNCH 1
#include <hip/hip_runtime.h>
#include <cstdint>
#include <cstdio>

#define LAS __attribute__((address_space(3)))
#define GAS __attribute__((address_space(1)))
typedef unsigned short bf16_t;
typedef short bf16x8 __attribute__((ext_vector_type(8)));
typedef float f32x4 __attribute__((ext_vector_type(4)));
typedef float f32x2 __attribute__((ext_vector_type(2)));
typedef float f32x16 __attribute__((ext_vector_type(16)));
typedef unsigned u32x4 __attribute__((ext_vector_type(4)));
typedef unsigned u32x2 __attribute__((ext_vector_type(2)));

namespace cfg {
constexpr int D = 1024, NB = 16, S = 2048, CTX = 256, NK = 2304, T = NB * S, TC = NB * CTX, TA = T + TC;
constexpr int H = 8, QL = 384, KVL = 256, AIN = 1696, AINP = 1792;
constexpr int CC = 512, CW = 31, SG = 2048, CH = 128;
constexpr int NE = 32, DE = 256, CAP_TILES = 288;
constexpr float QSCALE = 1.4426950408889634f * 0.10206207261596575f;
constexpr size_t MiB = (size_t)1 << 20;
constexpr size_t OFF_CTL = 0, CTL_BYTES = MiB;
constexpr size_t OFF_MOD = 1 * MiB, OFF_ROPE = 2 * MiB, OFF_RFRAG = 2 * MiB + 512 * 1024, OFF_RBIAS = 3 * MiB - 4096;
constexpr size_t OFF_WIN = 4 * MiB, OFF_WUQ = 7 * MiB + 512 * 1024, OFF_WUKV = 8 * MiB + 256 * 1024, OFF_WOUT = 9 * MiB, OFF_CIN = 11 * MiB, OFF_COUT = 19 * MiB, OFF_WSB = 23 * MiB;
constexpr size_t OFF_MGU = 24 * MiB, OFF_MDN = 88 * MiB;
constexpr size_t OFF_LIST = 120 * MiB, OFF_LISTW = 124 * MiB, OFF_TOKSLOT = 128 * MiB, OFF_SSQ = 129 * MiB;
constexpr size_t OFF_HB = 132 * MiB, OFF_PROJ = 204 * MiB, OFF_QN = 330 * MiB, OFF_KVN = 354 * MiB, OFF_Z = 377 * MiB;
constexpr size_t OFF_QRAW = 132 * MiB, OFF_KVRAW = 204 * MiB, OFF_Q = 276 * MiB, OFF_K = 324 * MiB, OFF_V = 378 * MiB, OFF_CONCAT = 414 * MiB, OFF_KR = 478 * MiB;
constexpr size_t OFF_H2 = 132 * MiB, OFF_ACT = 196 * MiB, OFF_HE = 232 * MiB, OFF_ZZ = 196 * MiB;
constexpr size_t OFF_VSTAT = 452 * MiB;
constexpr size_t WS_NEED = 483 * MiB;
static_assert(OFF_MOD + (size_t)2 * 17 * 6144 * 4 <= OFF_ROPE && OFF_ROPE + 2 * 2048 * 16 * 4 <= OFF_RFRAG && OFF_RFRAG + 2 * 32 * 3 * 2 * 1024 <= OFF_RBIAS, "tables");
static_assert(OFF_WIN + (size_t)AINP * 1024 * 2 <= OFF_WUQ && OFF_WUQ + 768 * 384 * 2 <= OFF_WUKV && OFF_WUKV + 1024 * 256 * 2 <= OFF_WOUT && OFF_WOUT + 1024 * 1024 * 2 <= OFF_CIN, "weights 1");
static_assert(OFF_CIN + (size_t)4096 * 1024 * 2 <= OFF_COUT && OFF_COUT + (size_t)1024 * 2048 * 2 <= OFF_WSB && OFF_WSB + 8 * 128 * 128 * 2 <= OFF_MGU, "weights 2");
static_assert(OFF_MGU + (size_t)2 * 32 * 512 * 1024 * 2 <= OFF_MDN && OFF_MDN + (size_t)2 * 32 * 1024 * 256 * 2 <= OFF_LIST && OFF_LIST + (size_t)32 * 32768 * 4 <= OFF_LISTW && OFF_LISTW + (size_t)32 * 32768 * 4 <= OFF_TOKSLOT && OFF_TOKSLOT + (size_t)T * 2 * 4 <= OFF_SSQ && OFF_SSQ + (size_t)T * 16 * 4 <= OFF_HB, "moe");
static_assert(OFF_HB + (size_t)TA * 1024 * 2 <= OFF_PROJ && OFF_PROJ + (size_t)TA * AINP * 2 <= OFF_QN && OFF_QN + (size_t)T * 384 * 2 <= OFF_KVN && OFF_KVN + (size_t)TA * 256 * 2 <= OFF_Z && OFF_Z + (size_t)T * 512 * 2 <= OFF_CONCAT, "act 1");
static_assert(OFF_QRAW + (size_t)T * 768 * 2 <= OFF_KVRAW && OFF_KVRAW + (size_t)TA * 1024 * 2 <= OFF_Q && OFF_Q + (size_t)T * 768 * 2 <= OFF_K && OFF_K + (size_t)128 * NK * 96 * 2 <= OFF_V && OFF_V + (size_t)128 * NK * 64 * 2 <= OFF_CONCAT, "act 2");
static_assert(OFF_CONCAT + (size_t)T * 1024 * 2 <= OFF_KR && OFF_KR + (size_t)TA * 32 * 4 <= WS_NEED, "act 3");
static_assert(OFF_H2 + (size_t)T * 1024 * 2 <= OFF_ACT && OFF_ACT + (size_t)CAP_TILES * 256 * 256 * 2 <= OFF_HE && OFF_HE + (size_t)CAP_TILES * 256 * 1024 * 2 <= WS_NEED && OFF_ZZ + (size_t)T * 4096 * 2 <= WS_NEED, "act 4");
constexpr int CW_BAR = 4096, CW_GCNT = 8192;
constexpr int LDS_TB = 131072, LDS_CNT = LDS_TB + 256, LDS_TOKL = LDS_TB + 512, LDS_WL = LDS_TOKL + 4096, LDS_UT = LDS_WL + 4096, LDS_MISC = LDS_UT + 256, LDS_BYTES = 147456;
static_assert(LDS_MISC + 64 <= LDS_BYTES, "lds map");
constexpr int NPHASE = 19;
}
namespace pg8 {
constexpr int BM = 256, BK = 64, HALF = 128, HTB = HALF * BK * 2, STAGE_BYTES = 8 * HTB, NXCD = 8, WGM = 8;
__host__ __device__ __forceinline__ int lds_byte(int r, int c) { const int st = (r >> 4) * 2 + (c >> 5), rr = r & 15, cc = c & 31, ob = rr * 64 + cc * 2; return st * 1024 + (ob ^ (((ob >> 9) & 1) << 5)); }
__host__ __device__ __forceinline__ void stage_rc(int b, int& R, int& C) { const int st = b / 1024, sb = b % 1024, swz = sb ^ (((sb >> 9) & 1) << 5); R = (st >> 1) * 16 + swz / 64; C = (st & 1) * 32 + (swz % 64) / 2; }
__host__ __device__ __forceinline__ int perm32(int rho) { const int n = rho >> 4, i = rho & 15; return 8 * (i >> 2) + 4 * n + (i & 3); }

struct Unit { int pm, pn, eb, aux; };
struct Gemm { const bf16_t* A; const bf16_t* Bt; int lda, ldb, K; size_t bstride; };

struct StaticOrder {
    int nM, nN, nwg, G, c;
    __device__ __forceinline__ void init(int M, int N, int G_, int c_) { nM = M / BM; nN = N / BM; nwg = nM * nN; G = G_; c = c_; }
    __device__ __forceinline__ bool next(int i, Unit& u) const {
        const long L = (long)i * G + c; if (L >= nwg) return false;
        int wgid = (int)L; { const int q = nwg / NXCD, r = nwg % NXCD, xcd = wgid % NXCD, off = wgid / NXCD; wgid = (xcd < r ? xcd * (q + 1) : r * (q + 1) + (xcd - r) * q) + off; }
        const int nig = WGM * nN, gid = wgid / nig, fm = gid * WGM, gsz = (nM - fm) < WGM ? (nM - fm) : WGM;
        u.pm = fm + ((wgid % nig) % gsz); u.pn = (wgid % nig) / gsz; u.eb = 0; u.aux = 0; return true;
    }
};
struct GroupedOrder {
    const volatile LAS int* ut; int n;
    __device__ __forceinline__ bool next(int i, Unit& u) const {
        if (i >= n) return false;
        u.pm = __builtin_amdgcn_readfirstlane(ut[4 * i]); u.pn = __builtin_amdgcn_readfirstlane(ut[4 * i + 1]); u.eb = __builtin_amdgcn_readfirstlane(ut[4 * i + 2]); u.aux = __builtin_amdgcn_readfirstlane(ut[4 * i + 3]); return true;
    }
};
__device__ __forceinline__ void build_units(volatile LAS int* ut, const LAS int* tb, int ncol, int G, int c) {
    const int nunits = tb[32] * ncol; int n = 0;
    for (int i = 0; i < 8; ++i) { const int L = i * G + c; if (L >= nunits) break; const int rt = L / ncol; int e = 0;
        for (int k = 1; k < 32; ++k) if (tb[k] <= rt) e = k;
        ut[4 * i] = rt; ut[4 * i + 1] = L - rt * ncol; ut[4 * i + 2] = e; ut[4 * i + 3] = rt - tb[e]; n = i + 1; }
    ut[32] = n;
}

__device__ __forceinline__ unsigned cvt_pk_bf16(float lo, float hi) { unsigned r; asm volatile("v_cvt_pk_bf16_f32 %0, %1, %2" : "=v"(r) : "v"(lo), "v"(hi)); return r; }
__device__ __forceinline__ float gelu_tanh_f(float v) { const float t = v * (-2.302208198f + -0.1029432397f * v * v); return v * __builtin_amdgcn_rcpf(1.0f + __builtin_amdgcn_exp2f(t)); }

template <int ACT> struct EpiBf16 {
    static constexpr bool PERM = true;
    bf16_t* O; int ldc; const float* bias; f32x2* stats; int stat_pn0;
    __device__ __forceinline__ void operator()(const f32x4 (&acc)[2][2][4][2], const Unit& u, int ui, int wr, int wc, int fr, int fq) const {
        const int row0 = u.pm * BM + wr * 64 + fr; const int col0 = u.pn * BM + wc * 32 + 8 * fq;
        const bool do_stat = stats != nullptr && u.pn >= stat_pn0;
        f32x4 bv[2][2];
#pragma unroll
        for (int bj = 0; bj < 2; ++bj)
#pragma unroll
            for (int n = 0; n < 2; ++n) bv[bj][n] = bias ? *(const f32x4*)(bias + col0 + bj * HALF + 4 * n) : (f32x4){0.f, 0.f, 0.f, 0.f};
#pragma unroll
        for (int ai = 0; ai < 2; ++ai)
#pragma unroll
            for (int m = 0; m < 4; ++m) { bf16_t* rowp = O + (size_t)(row0 + ai * HALF + m * 16) * ldc + col0; float s1 = 0.f, s2 = 0.f;
#pragma unroll
                for (int bj = 0; bj < 2; ++bj) { f32x4 v0 = acc[ai][bj][m][0] + bv[bj][0], v1 = acc[ai][bj][m][1] + bv[bj][1];
                    if (ACT == 1) {
#pragma unroll
                        for (int j = 0; j < 4; ++j) { v0[j] = gelu_tanh_f(v0[j]); v1[j] = gelu_tanh_f(v1[j]); } }
                    u32x4 w; w.x = cvt_pk_bf16(v0[0], v0[1]); w.y = cvt_pk_bf16(v0[2], v0[3]); w.z = cvt_pk_bf16(v1[0], v1[1]); w.w = cvt_pk_bf16(v1[2], v1[3]);
                    *(u32x4*)(rowp + bj * HALF) = w;
                    if (ACT == 1) { s1 += (v0[0] + v0[1]) + (v0[2] + v0[3]) + (v1[0] + v1[1]) + (v1[2] + v1[3]);
                        s2 += (v0[0] * v0[0] + v0[1] * v0[1]) + (v0[2] * v0[2] + v0[3] * v0[3]) + (v1[0] * v1[0] + v1[1] * v1[1]) + (v1[2] * v1[2] + v1[3] * v1[3]); } }
                if (ACT == 1) { if (do_stat) { s1 += __shfl_xor(s1, 16); s1 += __shfl_xor(s1, 32); s2 += __shfl_xor(s2, 16); s2 += __shfl_xor(s2, 32);
                    if (fq == 0) stats[(size_t)(row0 + ai * HALF + m * 16) * 32 + (u.pn - stat_pn0) * 4 + wc] = (f32x2){s1, s2}; } } }
    }
};
struct EpiResid {
    static constexpr bool PERM = false;
    const float* xi; float* xo; const float* gate; int gstride; bool dry; float* ssq;
    __device__ __forceinline__ void operator()(const f32x4 (&acc)[2][2][4][2], const Unit& u, int ui, int wr, int wc, int fr, int fq) const {
        const int row0 = u.pm * BM + wr * 64 + fr, col0 = u.pn * BM + wc * 32 + 4 * fq;
        const float* gp = gate + (size_t)((u.pm * BM) >> 11) * gstride + col0;
        f32x4 gv[2][2];
#pragma unroll
        for (int bj = 0; bj < 2; ++bj)
#pragma unroll
            for (int n = 0; n < 2; ++n) gv[bj][n] = *(const f32x4*)(gp + bj * HALF + n * 16);
#pragma unroll
        for (int ai = 0; ai < 2; ++ai)
#pragma unroll
            for (int m = 0; m < 4; ++m) { const size_t off = (size_t)(row0 + ai * HALF + m * 16) * 1024 + col0; float sq = 0.f;
#pragma unroll
                for (int bj = 0; bj < 2; ++bj)
#pragma unroll
                    for (int n = 0; n < 2; ++n) { const f32x4 xv = *(const f32x4*)(xi + off + bj * HALF + n * 16); const f32x4 rv = xv + gv[bj][n] * acc[ai][bj][m][n];
                        sq += (rv[0] * rv[0] + rv[1] * rv[1]) + (rv[2] * rv[2] + rv[3] * rv[3]);
                        if (!dry) *(f32x4*)(xo + off + bj * HALF + n * 16) = rv; else if (rv[0] == 1.2345e30f) *(f32x4*)(xo + off) = rv; }
                sq += __shfl_xor(sq, 16); sq += __shfl_xor(sq, 32);
                if (fq == 0) ssq[(size_t)(row0 + ai * HALF + m * 16) * 16 + u.pn * 4 + wc] = sq; }
    }
};
struct EpiAct {
    static constexpr bool PERM = false;
    bf16_t* O; const LAS float* wl;
    __device__ __forceinline__ void operator()(const f32x4 (&acc)[2][2][4][2], const Unit& u, int ui, int wr, int wc, int fr, int fq) const {
        const int col0 = u.pn * HALF + wc * 32 + 4 * fq;
#pragma unroll
        for (int ai = 0; ai < 2; ++ai)
#pragma unroll
            for (int m = 0; m < 4; ++m) { const int rt = ai * HALF + wr * 64 + m * 16 + fr; const float w = wl[ui * 256 + rt];
                bf16_t* rowp = O + (size_t)(u.pm * BM + rt) * 256 + col0;
#pragma unroll
                for (int n = 0; n < 2; ++n) { const f32x4 g = acc[ai][0][m][n], up = acc[ai][1][m][n]; f32x4 r;
#pragma unroll
                    for (int j = 0; j < 4; ++j) r[j] = w * up[j] * g[j] * __builtin_amdgcn_rcpf(1.0f + __builtin_amdgcn_exp2f(-1.4426950409f * g[j]));
                    u32x2 o; o.x = cvt_pk_bf16(r[0], r[1]); o.y = cvt_pk_bf16(r[2], r[3]); *(u32x2*)(rowp + n * 16) = o; } }
    }
};

template <class Epi, class Sched, bool GATHER>
__device__ __forceinline__ void gemm_phase(LAS unsigned char* lds, const Gemm g, const Sched& S, const Epi& E, const LAS int* tokl) {
    const int tid = threadIdx.x, wid = __builtin_amdgcn_readfirstlane(tid >> 6), lane = tid & 63, wr = wid >> 2, wc = wid & 3, fr = lane & 15, fq = lane >> 4;
    const int K = g.K, nt = K / BK;
    const size_t kstep = (size_t)(BK * 2);
    const size_t hstepB = (size_t)HALF * g.ldb * 2, tstepB = 2 * hstepB;
    const unsigned hstepA = (unsigned)HALF * g.lda * 2; const size_t tstepA = 2 * (size_t)hstepA;
    int Rs[2], Cs[2]; unsigned voffB[2];
#pragma unroll
    for (int i = 0; i < 2; ++i) { int R, C; stage_rc(tid * 16 + i * 8192, R, C); Rs[i] = R; Cs[i] = C; const int Rb = Epi::PERM ? ((R & ~31) + perm32(R & 31)) : R; voffB[i] = (unsigned)(Rb * g.ldb + C) * 2u; }
    unsigned offA[2][2], noffA[2][2];
#define PG8_SETOFF(dst, UI) do { _Pragma("unroll") for (int _h = 0; _h < 2; ++_h) _Pragma("unroll") for (int _i = 0; _i < 2; ++_i) { \
        if (GATHER) dst[_h][_i] = (unsigned)tokl[(UI) * 256 + _h * HALF + Rs[_i]] * (unsigned)(g.lda * 2) + (unsigned)Cs[_i] * 2u; \
        else dst[_h][_i] = (unsigned)_h * hstepA + (unsigned)(Rs[_i] * g.lda + Cs[_i]) * 2u; } } while (0)
    const unsigned ldsw = (unsigned)wid * 1024u;
    const int aoff = lds_byte(wr * 64 + fr, fq * 8), boff = lds_byte(wc * 32 + fr, fq * 8);
#define PG8_SA(b, h) (((b) * 2 + (h)) * HTB)
#define PG8_SB(b, h) ((4 + (b) * 2 + (h)) * HTB)
#define PG8_STAGE(bufoff, gbase, voff) do { _Pragma("unroll") for (int _i = 0; _i < 2; ++_i) \
        __builtin_amdgcn_global_load_lds((const unsigned*)((const char*)(gbase) + (voff)[_i]), (LAS unsigned*)(lds + (bufoff) + ldsw + _i * 8192), 16, 0, 0); } while (0)
#define PG8_LDA(dst, b, h) do { _Pragma("unroll") for (int m = 0; m < 4; ++m) _Pragma("unroll") for (int k = 0; k < 2; ++k) dst[m][k] = *(const LAS bf16x8*)(lds + PG8_SA(b, h) + aoff + m * 2048 + k * 1024); } while (0)
#define PG8_LDB(dst, b, h) do { _Pragma("unroll") for (int n = 0; n < 2; ++n) _Pragma("unroll") for (int k = 0; k < 2; ++k) dst[n][k] = *(const LAS bf16x8*)(lds + PG8_SB(b, h) + boff + n * 2048 + k * 1024); } while (0)
#define PG8_MMA(ai, bj, At, Bt) do { __builtin_amdgcn_s_setprio(1); _Pragma("unroll") for (int m = 0; m < 4; ++m) _Pragma("unroll") for (int n = 0; n < 2; ++n) _Pragma("unroll") for (int k = 0; k < 2; ++k) \
        acc[ai][bj][m][n] = __builtin_amdgcn_mfma_f32_16x16x32_bf16(Bt[n][k], At[m][k], acc[ai][bj][m][n], 0, 0, 0); __builtin_amdgcn_s_setprio(0); } while (0)
#define PG8_WAIT_V(n) asm volatile("s_waitcnt vmcnt(" #n ")" ::: "memory")
#define PG8_WAIT_L(n) asm volatile("s_waitcnt lgkmcnt(" #n ")" ::: "memory")
#define PG8_BAR __builtin_amdgcn_s_barrier()
#define PG8_SCHED __builtin_amdgcn_sched_barrier(0)
    Unit cur, nxt; int ui = 0;
    if (!S.next(0, cur)) return;
    f32x4 acc[2][2][4][2];
#pragma unroll
    for (int a = 0; a < 2; ++a)
#pragma unroll
        for (int b = 0; b < 2; ++b)
#pragma unroll
            for (int m = 0; m < 4; ++m)
#pragma unroll
                for (int n = 0; n < 2; ++n) acc[a][b][m][n] = (f32x4){0.f, 0.f, 0.f, 0.f};
    bf16x8 At[4][2], B0[2][2], B1[2][2];
    const char* cA = GATHER ? (const char*)g.A : (const char*)g.A + (size_t)cur.pm * tstepA;
    const char* cB = (const char*)g.Bt + ((size_t)cur.eb * g.bstride) * 2 + (size_t)cur.pn * tstepB;
    PG8_SETOFF(offA, 0);
#pragma unroll
    for (int _h = 0; _h < 2; ++_h)
#pragma unroll
        for (int _i = 0; _i < 2; ++_i) noffA[_h][_i] = offA[_h][_i];
    PG8_STAGE(PG8_SB(0, 0), cB, voffB); PG8_STAGE(PG8_SB(0, 1), cB + hstepB, voffB); PG8_STAGE(PG8_SA(0, 0), cA, offA[0]); PG8_STAGE(PG8_SA(0, 1), cA, offA[1]);
    if (wr == 1) PG8_BAR;
    PG8_WAIT_V(2); PG8_BAR;
    PG8_STAGE(PG8_SB(1, 0), cB + kstep, voffB); PG8_STAGE(PG8_SA(1, 0), cA + kstep, offA[0]); PG8_STAGE(PG8_SB(1, 1), cB + hstepB + kstep, voffB);
    PG8_WAIT_V(6); PG8_BAR;
    for (;;) {
        const bool has_next = S.next(ui + 1, nxt);
        const char* nA = has_next ? (GATHER ? (const char*)g.A : (const char*)g.A + (size_t)nxt.pm * tstepA) : cA;
        const char* nB = has_next ? (const char*)g.Bt + ((size_t)nxt.eb * g.bstride) * 2 + (size_t)nxt.pn * tstepB : cB;
        if (GATHER && has_next) PG8_SETOFF(noffA, ui + 1);
#pragma unroll 1
        for (int t = 0; t < nt; t += 2) {
            const bool last = (t == nt - 2);
            const char* a1 = cA + (size_t)(t + 1) * kstep;
            const char* a2 = last ? nA : cA + (size_t)(t + 2) * kstep; const char* b2 = last ? nB : cB + (size_t)(t + 2) * kstep;
            const char* a3 = a2 + kstep; const char* b3 = b2 + kstep;
            unsigned o2[2][2];
#pragma unroll
            for (int _h = 0; _h < 2; ++_h)
#pragma unroll
                for (int _i = 0; _i < 2; ++_i) o2[_h][_i] = (GATHER && last) ? noffA[_h][_i] : offA[_h][_i];
            PG8_LDB(B0, 0, 0); PG8_LDB(B1, 0, 1); PG8_SCHED; PG8_LDA(At, 0, 0); PG8_STAGE(PG8_SA(1, 1), a1, offA[1]);
            PG8_WAIT_V(8); PG8_WAIT_L(0); PG8_BAR; PG8_MMA(0, 0, At, B0); PG8_MMA(0, 1, At, B1); PG8_BAR; PG8_SCHED;
            PG8_LDA(At, 0, 1); PG8_STAGE(PG8_SB(0, 0), b2, voffB); PG8_STAGE(PG8_SB(0, 1), b2 + hstepB, voffB); PG8_STAGE(PG8_SA(0, 0), a2, o2[0]);
            PG8_WAIT_V(8); PG8_WAIT_L(0); PG8_BAR; PG8_MMA(1, 0, At, B0); PG8_MMA(1, 1, At, B1); PG8_BAR; PG8_SCHED;
            PG8_LDB(B0, 1, 0); PG8_LDB(B1, 1, 1); PG8_SCHED; PG8_LDA(At, 1, 0); PG8_STAGE(PG8_SA(0, 1), a2, o2[1]);
            PG8_WAIT_V(8); PG8_WAIT_L(0); PG8_BAR; PG8_MMA(0, 0, At, B0); PG8_MMA(0, 1, At, B1); PG8_BAR; PG8_SCHED;
            PG8_LDA(At, 1, 1); PG8_STAGE(PG8_SB(1, 0), b3, voffB); PG8_STAGE(PG8_SB(1, 1), b3 + hstepB, voffB); PG8_STAGE(PG8_SA(1, 0), a3, o2[0]);
            PG8_WAIT_V(8); PG8_WAIT_L(0); PG8_BAR; PG8_MMA(1, 0, At, B0); PG8_MMA(1, 1, At, B1); PG8_BAR; PG8_SCHED;
        }
        if (wr == 0) PG8_BAR;
        E(acc, cur, ui, wr, wc, fr, fq);
        if (!has_next) break;
#pragma unroll
        for (int a = 0; a < 2; ++a)
#pragma unroll
            for (int b = 0; b < 2; ++b)
#pragma unroll
                for (int m = 0; m < 4; ++m)
#pragma unroll
                    for (int n = 0; n < 2; ++n) acc[a][b][m][n] = (f32x4){0.f, 0.f, 0.f, 0.f};
        cur = nxt; cA = nA; cB = nB; ++ui;
        if (GATHER) {
#pragma unroll
            for (int _h = 0; _h < 2; ++_h)
#pragma unroll
                for (int _i = 0; _i < 2; ++_i) offA[_h][_i] = noffA[_h][_i]; }
        if (wr == 1) PG8_BAR;
    }
    PG8_WAIT_V(0);
    PG8_BAR;
#undef PG8_SETOFF
#undef PG8_SA
#undef PG8_SB
#undef PG8_STAGE
#undef PG8_LDA
#undef PG8_LDB
#undef PG8_MMA
#undef PG8_WAIT_V
#undef PG8_WAIT_L
#undef PG8_BAR
#undef PG8_SCHED
}
}
namespace att {
constexpr int NKEY = 2304, KT = 64, NT = NKEY / KT, KSLOT = 12288, VSLOT = 8192;
constexpr int LDS_K = 0, LDS_V = 2 * KSLOT, LDS_WS = LDS_V + 2 * VSLOT, LDS_BYTES = LDS_WS + 8 * 256;
__device__ __forceinline__ int crow(int r, int hi) { return (r & 3) + 8 * (r >> 2) + 4 * hi; }
typedef short s16x4 __attribute__((ext_vector_type(4)));
__device__ __forceinline__ unsigned cvtpk(float lo, float hi) { unsigned r; asm volatile("v_cvt_pk_bf16_f32 %0, %1, %2" : "=v"(r) : "v"(lo), "v"(hi)); return r; }

__device__ __forceinline__ void attn_unit(int bh, int qb, const bf16_t* Q, const bf16_t* K, const bf16_t* V, bf16_t* concat, LAS unsigned char* lds) {
    const int tid = threadIdx.x, lane = tid & 63, r32 = lane & 31, hi = lane >> 5; const int wid = __builtin_amdgcn_readfirstlane(tid >> 6);
    const bf16_t* Qw = Q + ((size_t)bh * 2048 + qb * 256 + wid * 32) * 96;
    const bf16_t* Kh = K + (size_t)bh * NKEY * 96; const bf16_t* Vh = V + (size_t)bh * NKEY * 64;
    LAS float* wsf = (LAS float*)(lds + LDS_WS) + wid * 64;
    const bf16_t* ksrc0 = Kh + (size_t)lane * 96 + wid * 8;
    const bf16_t* ksrc1 = Kh + (size_t)lane * 96 + (8 + (wid & 3)) * 8;
    const bf16_t* vsrc = Vh + (size_t)(16 * (wid & 3) + (lane >> 2)) * 64 + (wid >> 2) * 32 + (lane & 3) * 8;
#define ATT_DMA(t, slot) do { \
        __builtin_amdgcn_global_load_lds((const unsigned*)(ksrc0 + (size_t)(t) * KT * 96), (LAS unsigned*)(lds + LDS_K + (slot) * KSLOT + wid * 1024), 16, 0, 0); \
        if (wid < 4) __builtin_amdgcn_global_load_lds((const unsigned*)(ksrc1 + (size_t)(t) * KT * 96), (LAS unsigned*)(lds + LDS_K + (slot) * KSLOT + (8 + wid) * 1024), 16, 0, 0); \
        __builtin_amdgcn_global_load_lds((const unsigned*)(vsrc + (size_t)(t) * KT * 64), (LAS unsigned*)(lds + LDS_V + (slot) * VSLOT + wid * 1024), 16, 0, 0); } while (0)
    ATT_DMA(0, 0);
    bf16x8 qr[6];
#pragma unroll
    for (int d0 = 0; d0 < 6; ++d0) qr[d0] = *(const bf16x8*)(Qw + (size_t)r32 * 96 + d0 * 16 + hi * 8);
    float m_run = -1e30f, l_run = 0.f; f32x16 o[2]; o[0] = (f32x16){}; o[1] = (f32x16){};
    const int kfo = hi * 1024 + r32 * 16;
    const int vfo = ((lane >> 4) & 1) * 32 + (lane & 3) * 8 + (4 * hi + ((lane & 15) >> 2)) * 64;
#pragma unroll 1
    for (int t = 0; t < NT; ++t) {
        asm volatile("s_waitcnt vmcnt(0)\n\ts_barrier" ::: "memory");
        const int slot = t & 1;
        if (t + 1 < NT) ATT_DMA(t + 1, slot ^ 1);
        const LAS unsigned char* kb = lds + LDS_K + slot * KSLOT + kfo;
        f32x16 p0 = (f32x16){}, p1 = (f32x16){};
#pragma unroll
        for (int d0 = 0; d0 < 6; ++d0) {
            const bf16x8 k0 = *(const LAS bf16x8*)(kb + d0 * 2048);
            const bf16x8 k1 = *(const LAS bf16x8*)(kb + d0 * 2048 + 512);
            p0 = __builtin_amdgcn_mfma_f32_32x32x16_bf16(k0, qr[d0], p0, 0, 0, 0);
            p1 = __builtin_amdgcn_mfma_f32_32x32x16_bf16(k1, qr[d0], p1, 0, 0, 0);
        }
        float mx = p0[0];
#pragma unroll
        for (int r = 1; r < 16; ++r) mx = fmaxf(mx, p0[r]);
#pragma unroll
        for (int r = 0; r < 16; ++r) mx = fmaxf(mx, p1[r]);
        mx = fmaxf(mx, __shfl_xor(mx, 32));
        const float m_new = fmaxf(m_run, mx);
        const float alpha = __builtin_amdgcn_exp2f(m_run - m_new);
        const bool changed = !__all(m_new == m_run);
        m_run = m_new;
        float ls = 0.f;
#pragma unroll
        for (int r = 0; r < 16; ++r) { p0[r] = __builtin_amdgcn_exp2f(p0[r] - m_new); p1[r] = __builtin_amdgcn_exp2f(p1[r] - m_new); ls += p0[r] + p1[r]; }
        l_run = l_run * alpha + ls;
        if (changed) {
            if (hi == 0) wsf[r32] = alpha;
            asm volatile("s_waitcnt lgkmcnt(0)" ::: "memory");
#pragma unroll
            for (int r = 0; r < 16; ++r) { const float a = wsf[crow(r, hi)]; o[0][r] *= a; o[1][r] *= a; }
        }
        u32x4 pw[4];
        pw[0] = (u32x4){cvtpk(p0[0], p0[1]), cvtpk(p0[2], p0[3]), cvtpk(p0[4], p0[5]), cvtpk(p0[6], p0[7])};
        pw[1] = (u32x4){cvtpk(p0[8], p0[9]), cvtpk(p0[10], p0[11]), cvtpk(p0[12], p0[13]), cvtpk(p0[14], p0[15])};
        pw[2] = (u32x4){cvtpk(p1[0], p1[1]), cvtpk(p1[2], p1[3]), cvtpk(p1[4], p1[5]), cvtpk(p1[6], p1[7])};
        pw[3] = (u32x4){cvtpk(p1[8], p1[9]), cvtpk(p1[10], p1[11]), cvtpk(p1[12], p1[13]), cvtpk(p1[14], p1[15])};
        const LAS unsigned char* vp = lds + LDS_V + slot * VSLOT + vfo;
#pragma unroll
        for (int d0 = 0; d0 < 2; ++d0)
#pragma unroll
            for (int ks = 0; ks < 4; ++ks) {
                const s16x4 lo = __builtin_bit_cast(s16x4, __builtin_amdgcn_ds_read_tr16_b64_v4i16((LAS s16x4*)(vp + d0 * 4096 + ks * 1024)));
                const s16x4 hh = __builtin_bit_cast(s16x4, __builtin_amdgcn_ds_read_tr16_b64_v4i16((LAS s16x4*)(vp + d0 * 4096 + ks * 1024 + 512)));
                const bf16x8 vf = (bf16x8){lo[0], lo[1], lo[2], lo[3], hh[0], hh[1], hh[2], hh[3]};
                o[d0] = __builtin_amdgcn_mfma_f32_32x32x16_bf16(__builtin_bit_cast(bf16x8, pw[ks]), vf, o[d0], 0, 0, 0);
            }
    }
    l_run += __shfl_xor(l_run, 32);
    if (hi == 0) wsf[32 + r32] = l_run;
    asm volatile("s_waitcnt lgkmcnt(0)" ::: "memory");
    const int b = bh >> 3, h = bh & 7;
    bf16_t* Ow = concat + ((size_t)b * 2048 + qb * 256 + wid * 32) * 1024 + h * 64 + r32;
#pragma unroll
    for (int r = 0; r < 16; ++r) { const int q = crow(r, hi); const float rl = __builtin_amdgcn_rcpf(wsf[32 + q]);
        const unsigned w = cvtpk(o[0][r] * rl, o[1][r] * rl);
        Ow[(size_t)q * 1024] = (bf16_t)(w & 0xffffu); Ow[(size_t)q * 1024 + 32] = (bf16_t)(w >> 16); }
#undef ATT_DMA
}
}
__device__ __forceinline__ float wave_sum(float v) {
#pragma unroll
    for (int o = 1; o < 64; o <<= 1) v += __shfl_xor(v, o);
    return v;
}
__device__ __forceinline__ float bf2f(unsigned short b) { return __uint_as_float(((unsigned)b) << 16); }
__device__ __forceinline__ float bflo(unsigned w) { return __uint_as_float(w << 16); }
__device__ __forceinline__ float bfhi(unsigned w) { return __uint_as_float(w & 0xffff0000u); }
__device__ __forceinline__ unsigned pk2(float lo, float hi) { return pg8::cvt_pk_bf16(lo, hi); }
__device__ __forceinline__ float silu_fast(float v) { return v * __builtin_amdgcn_rcpf(1.0f + __builtin_amdgcn_exp2f(-1.4426950409f * v)); }
__device__ __forceinline__ float sigmoid_fast(float v) { return __builtin_amdgcn_rcpf(1.0f + __builtin_amdgcn_exp2f(-1.4426950409f * v)); }

struct TDesc { const float* src; bf16_t* dst; const float* ks; int ldw, ldt; };
__device__ __forceinline__ void t_load(const TDesc& d, f32x4 (&v)[8], int lane) {
    const int cr = lane & 7, rr = lane >> 3;
#pragma unroll
    for (int i = 0; i < 8; ++i) v[i] = *(const f32x4*)(d.src + (size_t)(8 * i + rr) * d.ldw + 4 * cr);
}
__device__ __forceinline__ void t_finish(const TDesc& d, f32x4 (&v)[8], LAS float* scr, int lane) {
    const int cr = lane & 7, rr = lane >> 3;
#pragma unroll
    for (int i = 0; i < 8; ++i) { const int kk = 8 * i + rr; if (d.ks) v[i] = v[i] * d.ks[kk];
        scr[kk * 33 + 4 * cr] = v[i].x; scr[kk * 33 + 4 * cr + 1] = v[i].y; scr[kk * 33 + 4 * cr + 2] = v[i].z; scr[kk * 33 + 4 * cr + 3] = v[i].w; }
    asm volatile("s_waitcnt lgkmcnt(0)" ::: "memory");
    const int c = lane & 7;
#pragma unroll
    for (int j = 0; j < 4; ++j) { const int n = (lane >> 3) + 8 * j; const LAS float* s = scr + (8 * c) * 33 + n;
        u32x4 o; o.x = pk2(s[0 * 33], s[1 * 33]); o.y = pk2(s[2 * 33], s[3 * 33]); o.z = pk2(s[4 * 33], s[5 * 33]); o.w = pk2(s[6 * 33], s[7 * 33]);
        *(u32x4*)(d.dst + (size_t)n * d.ldt + 8 * c) = o; }
    asm volatile("s_waitcnt lgkmcnt(0)" ::: "memory");
}
__device__ __forceinline__ TDesc t_make(const float* W, int ldw, int k0, int n0, bf16_t* WT, int ldt, int dst_row0, const float* kscale) {
    TDesc d; d.src = W + (size_t)k0 * ldw + n0; d.dst = WT + (size_t)dst_row0 * ldt + k0; d.ks = kscale ? kscale + k0 : nullptr; d.ldw = ldw; d.ldt = ldt; return d;
}

__device__ __forceinline__ void norm_mod_row(const float* xr, const float* g, const float* shift, const float* scale, bf16_t* orow, int lane) {
    f32x4 v[4]; float ss = 0.f;
#pragma unroll
    for (int j = 0; j < 4; ++j) { v[j] = *(const f32x4*)(xr + 4 * lane + 256 * j); ss += (v[j].x * v[j].x + v[j].y * v[j].y) + (v[j].z * v[j].z + v[j].w * v[j].w); }
    const float rstd = 1.0f / sqrtf(wave_sum(ss) * (1.0f / 1024.0f) + 1e-6f);
#pragma unroll
    for (int j = 0; j < 4; ++j) { const int c = 4 * lane + 256 * j; const f32x4 gg = *(const f32x4*)(g + c), sc = *(const f32x4*)(scale + c), sh = *(const f32x4*)(shift + c);
        const f32x4 y = v[j] * rstd * gg * (sc + 1.0f) + sh; u32x2 o; o.x = pk2(y.x, y.y); o.y = pk2(y.z, y.w); *(u32x2*)(orow + c) = o; }
}
#define XB_TMO      128
#define XB_XCNT(j)  (256  + 64 * (j))
#define XB_XSUB(j)  (1280 + 64 * (j))
#define XB_XGEN(j)  (2304 + 64 * (j))
#define XB_TOP      3328
#define XB_TOPGEN   3392
#define XCD_BAR_WORDS 3456
#define XB_SPIN_CAP (1u << 18)
__device__ __forceinline__ unsigned xb_ld(unsigned* p)              { return __hip_atomic_load(p, __ATOMIC_RELAXED, __HIP_MEMORY_SCOPE_AGENT); }
__device__ __forceinline__ unsigned xb_add(unsigned* p, unsigned v) { return __hip_atomic_fetch_add(p, v, __ATOMIC_RELAXED, __HIP_MEMORY_SCOPE_AGENT); }
__device__ __forceinline__ unsigned xb_xcc_id() { return (unsigned)__builtin_amdgcn_s_getreg((3 << 11) | 20) & 0xFu; }
#define XB_SPIN(cond, bar) do { unsigned _sp = 0; while (cond) { __builtin_amdgcn_s_sleep(1); \
    if ((++_sp & 255u) == 0u) { if (xb_ld(&(bar)[XB_TMO])) break; if (_sp > XB_SPIN_CAP) { atomicAdd(&(bar)[XB_TMO], 1u); break; } } } } while (0)
struct XcdBarrier { unsigned* bar; unsigned x; volatile LAS unsigned* st; };
__device__ __forceinline__ XcdBarrier xcd_barrier_post(unsigned* bar, volatile LAS unsigned* st) {
    XcdBarrier b; b.bar = bar; b.x = xb_xcc_id(); b.st = st;
    if (threadIdx.x == 0) (void)xb_add(&bar[XB_XCNT(b.x)], 1u);
    return b;
}
__device__ __forceinline__ void xcd_barrier_complete(unsigned* bar, unsigned x, unsigned& nloc, unsigned& nx) {
    const unsigned G = gridDim.x * gridDim.y * gridDim.z;
    unsigned sum, cnt, mine, sp = 0u;
    for (;;) {
        sum = 0u; cnt = 0u; mine = 0u;
#pragma unroll
        for (unsigned j = 0; j < 16; ++j) { const unsigned c = xb_ld(&bar[XB_XCNT(j)]); sum += c; cnt += (c > 0u) ? 1u : 0u; mine = (j == x) ? c : mine; }
        if (sum == G) break;
        __builtin_amdgcn_s_sleep(1);
        if ((++sp & 255u) == 0u) { if (xb_ld(&bar[XB_TMO])) break; if (sp > XB_SPIN_CAP) { atomicAdd(&bar[XB_TMO], 1u); break; } }
    }
    nloc = mine > 0u ? mine : 1u; nx = cnt > 0u ? cnt : 1u;
}
__device__ __forceinline__ void xcd_barrier(const XcdBarrier& b) {
    asm volatile("s_waitcnt vmcnt(0)" ::: "memory");
    __syncthreads();
    if (threadIdx.x == 0) {
        unsigned* bar = b.bar;
        __builtin_amdgcn_s_waitcnt(0);
        unsigned nloc = b.st[0], nx = b.st[1];
        if (nloc == 0u) { xcd_barrier_complete(bar, b.x, nloc, nx); b.st[0] = nloc; b.st[1] = nx; }
        const unsigned old = xb_add(&bar[XB_XSUB(b.x)], 1u);
        const unsigned gen = old / nloc;
        if (old + 1u == (gen + 1u) * nloc) {
            __builtin_amdgcn_fence(__ATOMIC_RELEASE, "agent");
            asm volatile("s_waitcnt vmcnt(0)" ::: "memory");
            const unsigned og = xb_add(&bar[XB_TOP], 1u);
            const unsigned tg = og / nx;
            if (og + 1u == (tg + 1u) * nx) xb_add(&bar[XB_TOPGEN], 1u);
            else XB_SPIN(xb_ld(&bar[XB_TOPGEN]) == tg, bar);
            __builtin_amdgcn_fence(__ATOMIC_ACQUIRE, "agent");
            xb_add(&bar[XB_XGEN(b.x)], 1u);
            asm volatile("s_waitcnt vmcnt(0)" ::: "memory");
        } else {
            XB_SPIN(xb_ld(&bar[XB_XGEN(b.x)]) == gen, bar);
            __builtin_amdgcn_fence(__ATOMIC_ACQUIRE, "agent");
            asm volatile("s_waitcnt vmcnt(0)" ::: "memory");
        }
    }
    __syncthreads();
}

struct Args { const float* in[34]; float* out; unsigned char* ws; int ph_lo, ph_hi, dry, pad; };
static_assert(sizeof(Args) == 36 * 8 + 16, "Args has no padding");

#ifndef PHASE_MASK
#define PHASE_MASK 0x7ffff
#endif
#define IN(k) (((PHASE_MASK >> (k)) & 1) && lo <= (k) && (k) < hi)
#define SEAM(k) do { if (IN(k) && IN((k) + 1)) xcd_barrier(bar); } while (0)
#define DECL_LOCALS \
    const int tid = threadIdx.x, lane = tid & 63, wid = __builtin_amdgcn_readfirstlane(tid >> 6); \
    const int G = gridDim.x, bx = blockIdx.x; \
    const int gw = bx * 8 + wid, NGW = G * 8; \
    const int lo = a.ph_lo, hi = a.ph_hi; const bool dry = a.dry != 0; \
    unsigned char* ws = a.ws; \
    unsigned* ctl = (unsigned*)(ws + OFF_CTL); \
    const float* x = a.in[0]; const float* cvec = a.in[1]; const float* ctx = a.in[2]; const float* cctx = a.in[3]; \
    const float* w_ada = a.in[4]; const float* b_ada = a.in[5]; const float* n1g = a.in[6]; const float* n2g = a.in[7]; \
    const float* a_w_in = a.in[8]; const float* a_qng = a.in[9]; const float* a_w_uq = a.in[10]; const float* a_kvng = a.in[11]; \
    const float* a_w_ukv = a.in[12]; const float* a_qg = a.in[13]; const float* a_kg = a.in[14]; \
    const float* b_w_dw = a.in[15]; const float* b_b_dw = a.in[16]; const float* b_ln_g = a.in[17]; const float* b_ln_b = a.in[18]; \
    const float* ab_w_out = a.in[19]; const float* c_w_in = a.in[20]; const float* c_b_in = a.in[21]; const float* c_ln_g = a.in[22]; \
    const float* c_ln_b = a.in[23]; const float* c_w_s = a.in[24]; const float* c_b_s = a.in[25]; const float* c_w_out = a.in[26]; \
    const float* m_wg = a.in[27]; const float* m_bg = a.in[28]; const float* m_wr = a.in[29]; const float* m_br = a.in[30]; \
    const float* m_gate = a.in[31]; const float* m_up = a.in[32]; const float* m_down = a.in[33]; \
    float* xres = a.out; \
    float* mod = (float*)(ws + OFF_MOD); float* ropec = (float*)(ws + OFF_ROPE); float* ropes = ropec + 2048 * 16; \
    bf16_t* rfrag = (bf16_t*)(ws + OFF_RFRAG); float* rbias = (float*)(ws + OFF_RBIAS); \
    bf16_t* WIN_T = (bf16_t*)(ws + OFF_WIN); bf16_t* WUQ_T = (bf16_t*)(ws + OFF_WUQ); bf16_t* WUKV_T = (bf16_t*)(ws + OFF_WUKV); bf16_t* WOUT_T = (bf16_t*)(ws + OFF_WOUT); \
    bf16_t* CIN_T = (bf16_t*)(ws + OFF_CIN); bf16_t* COUT_T = (bf16_t*)(ws + OFF_COUT); bf16_t* WSB = (bf16_t*)(ws + OFF_WSB); \
    bf16_t* MGU_T = (bf16_t*)(ws + OFF_MGU); bf16_t* MDN_T = (bf16_t*)(ws + OFF_MDN); \
    int* list = (int*)(ws + OFF_LIST); float* listw = (float*)(ws + OFF_LISTW); int* tokslot = (int*)(ws + OFF_TOKSLOT); float* ssq = (float*)(ws + OFF_SSQ); \
    bf16_t* hb = (bf16_t*)(ws + OFF_HB); bf16_t* proj = (bf16_t*)(ws + OFF_PROJ); bf16_t* qn = (bf16_t*)(ws + OFF_QN); bf16_t* kvn = (bf16_t*)(ws + OFF_KVN); bf16_t* zb = (bf16_t*)(ws + OFF_Z); \
    bf16_t* qraw = (bf16_t*)(ws + OFF_QRAW); bf16_t* kvraw = (bf16_t*)(ws + OFF_KVRAW); bf16_t* Qb = (bf16_t*)(ws + OFF_Q); bf16_t* Kb = (bf16_t*)(ws + OFF_K); bf16_t* Vb = (bf16_t*)(ws + OFF_V); \
    bf16_t* concat = (bf16_t*)(ws + OFF_CONCAT); float* krb = (float*)(ws + OFF_KR); \
    bf16_t* h2 = (bf16_t*)(ws + OFF_H2); bf16_t* actb = (bf16_t*)(ws + OFF_ACT); bf16_t* heb = (bf16_t*)(ws + OFF_HE); bf16_t* zz = (bf16_t*)(ws + OFF_ZZ); \
    (void)0;

template <int l> __device__ __forceinline__ void layer_tail(const Args& a, LAS unsigned char* lds, const XcdBarrier& bar) {
    using namespace cfg;
    DECL_LOCALS
        if (l == 1) {
            if (IN(12)) {
                pg8::Gemm g{hb, CIN_T, 1024, 1024, 1024, 0}; pg8::StaticOrder S; S.init(T, 4096, G, bx);
                pg8::EpiBf16<1> E{zz, 4096, c_b_in, (f32x2*)(ws + OFF_VSTAT), 8};
                pg8::gemm_phase<pg8::EpiBf16<1>, pg8::StaticOrder, false>(lds, g, S, E, nullptr);
            }
            SEAM(12);
            if (IN(13)) {
                LAS unsigned char* VT = lds; LAS f32x2* stat = (LAS f32x2*)(lds + 69632);
                const f32x2* vstat = (const f32x2*)(ws + OFF_VSTAT);
                const int g4 = lane >> 4, qq = (lane & 15) >> 2, p4 = lane & 3;
                const int cc = tid & 31, q0 = tid >> 5;
                for (int n = bx; n < 256; n += G) {
                    const size_t R0 = (size_t)n * 128;
                    __syncthreads();
                    { const int row = tid >> 2, qd = tid & 3; const f32x2* sp = vstat + (R0 + row) * 32 + qd * 8; float s1 = 0.f, s2 = 0.f;
#pragma unroll
                      for (int j = 0; j < 8; ++j) { const f32x2 t = sp[j]; s1 += t.x; s2 += t.y; }
                      s1 += __shfl_xor(s1, 1); s1 += __shfl_xor(s1, 2); s2 += __shfl_xor(s2, 1); s2 += __shfl_xor(s2, 2);
                      const float mean = s1 * (1.0f / 2048.0f), var = fmaxf(s2 * (1.0f / 2048.0f) - mean * mean, 0.f);
                      if (qd == 0) stat[row] = (f32x2){mean, 1.0f / sqrtf(var + 1e-5f)}; }
                    u32x4 vp[8];
#pragma unroll
                    for (int j = 0; j < 8; ++j) vp[j] = *(const u32x4*)(zz + (R0 + q0 + 16 * j) * 4096 + 2048 + 8 * cc);
                    const int prow = 16 * wid + (lane & 15);
                    for (int g = 0; g < 8; ++g) {
                        const f32x4 lg0 = *(const f32x4*)(c_ln_g + 256 * g + 8 * cc), lg1 = *(const f32x4*)(c_ln_g + 256 * g + 8 * cc + 4), lb0 = *(const f32x4*)(c_ln_b + 256 * g + 8 * cc), lb1 = *(const f32x4*)(c_ln_b + 256 * g + 8 * cc + 4);
                        __syncthreads();
#pragma unroll
                        for (int j = 0; j < 8; ++j) { const int q = q0 + 16 * j; const u32x4 w = vp[j]; const f32x2 st = stat[q];
                            const f32x4 a0 = ((f32x4){bflo(w.x), bfhi(w.x), bflo(w.y), bfhi(w.y)} - st.x) * st.y * lg0 + lb0, a1 = ((f32x4){bflo(w.z), bfhi(w.z), bflo(w.w), bfhi(w.w)} - st.x) * st.y * lg1 + lb1;
                            *(LAS u32x4*)(VT + q * 544 + cc * 16) = (u32x4){pk2(a0.x, a0.y), pk2(a0.z, a0.w), pk2(a1.x, a1.y), pk2(a1.z, a1.w)}; }
                        __syncthreads();
                        if (g < 7) {
#pragma unroll
                            for (int j = 0; j < 8; ++j) vp[j] = *(const u32x4*)(zz + (R0 + q0 + 16 * j) * 4096 + 2048 + 256 * (g + 1) + 8 * cc); }
                        bf16_t* urow = zz + (R0 + prow) * 4096 + 256 * g + 4 * g4;
                        u32x2 uw[16];
#pragma unroll
                        for (int mb = 0; mb < 16; ++mb) uw[mb] = *(const u32x2*)(urow + 16 * mb);
                        bf16x8 bfr[4];
#pragma unroll
                        for (int kb = 0; kb < 4; ++kb) bfr[kb] = *(const bf16x8*)(WSB + ((size_t)(g * 128 + prow)) * 128 + 32 * kb + 8 * g4);
                        const float bs = c_b_s[g * 128 + prow];
                        f32x4 acc[16];
#pragma unroll
                        for (int mb = 0; mb < 16; ++mb) acc[mb] = (f32x4){0.f, 0.f, 0.f, 0.f};
#pragma unroll
                        for (int kb = 0; kb < 4; ++kb) {
#pragma unroll
                            for (int mb = 0; mb < 16; ++mb) { const LAS unsigned char* ap = VT + (32 * kb + 8 * g4 + qq) * 544 + 32 * mb + 8 * p4;
                                const att::s16x4 t0 = __builtin_bit_cast(att::s16x4, __builtin_amdgcn_ds_read_tr16_b64_v4i16((LAS att::s16x4*)(ap)));
                                const att::s16x4 t1 = __builtin_bit_cast(att::s16x4, __builtin_amdgcn_ds_read_tr16_b64_v4i16((LAS att::s16x4*)(ap + 4 * 544)));
                                const bf16x8 af = (bf16x8){t0[0], t0[1], t0[2], t0[3], t1[0], t1[1], t1[2], t1[3]};
                                acc[mb] = __builtin_amdgcn_mfma_f32_16x16x32_bf16(af, bfr[kb], acc[mb], 0, 0, 0); }
                        }
#pragma unroll
                        for (int mb = 0; mb < 16; ++mb) { u32x2 o; o.x = pk2(bflo(uw[mb].x) * (acc[mb][0] + bs), bfhi(uw[mb].x) * (acc[mb][1] + bs)); o.y = pk2(bflo(uw[mb].y) * (acc[mb][2] + bs), bfhi(uw[mb].y) * (acc[mb][3] + bs));
                            if (!dry) *(u32x2*)(urow + 16 * mb) = o; }
                    }
                }
            }
            SEAM(13);
            if (IN(14)) {
                pg8::Gemm g{zz, COUT_T, 4096, 2048, 2048, 0}; pg8::StaticOrder S; S.init(T, 1024, G, bx);
                pg8::EpiResid E{xres, xres, mod + (size_t)17 * 6144 + 2048, 6144, dry, ssq};
                pg8::gemm_phase<pg8::EpiResid, pg8::StaticOrder, false>(lds, g, S, E, nullptr);
            }
            SEAM(14);
        }
        const int pb = l ? 15 : 8;
        const float* modl = mod + (size_t)l * 17 * 6144;
        unsigned* gcnt = ctl + CW_GCNT + l * 32 * 64;
        LAS int* tb = (LAS int*)(lds + LDS_TB); LAS int* cntl = (LAS int*)(lds + LDS_CNT);
        if (IN(pb)) {
            LAS float* lg = (LAS float*)lds + wid * 768;
            LAS int* hist = (LAS int*)(lds + 32768); LAS int* hist2 = hist + 32; LAS int* basel = hist + 64;
            LAS float* Av = (LAS float*)(lds + 40960); LAS float* Bv = Av + 1024;
            const float* gn = n2g + l * 1024; const bf16_t* rf = rfrag + (size_t)l * 32 * 3 * 2 * 512;
            const int r16 = lane & 15, kg = lane >> 4;
            for (int blk = bx; blk < 256; blk += G) {
                const int t0 = blk * 128 + wid * 16, tok = t0 + r16; const float* md = modl + (size_t)(t0 >> 11) * 6144;
                __syncthreads();
                if (tid < 64) hist[tid] = 0;
                for (int i = tid; i < 1024; i += 512) { Av[i] = gn[i] * (md[4096 + i] + 1.0f); Bv[i] = md[3072 + i]; }
                const float* xr = xres + (size_t)tok * 1024 + 8 * kg;
                float ss; { const f32x4 pq = *(const f32x4*)(ssq + (size_t)tok * 16 + 4 * kg); ss = (pq.x + pq.y) + (pq.z + pq.w); }
                ss += __shfl_xor(ss, 16); ss += __shfl_xor(ss, 32);
                const float rstd = 1.0f / sqrtf(ss * (1.0f / 1024.0f) + 1e-6f);
                f32x4 acc[3];
#pragma unroll
                for (int cb = 0; cb < 3; ++cb) acc[cb] = (f32x4){0.f, 0.f, 0.f, 0.f};
                f32x4 xq[4][2]; bf16x8 wq[2][6];
#pragma unroll
                for (int j = 0; j < 4; ++j) { xq[j][0] = *(const f32x4*)(xr + 32 * j); xq[j][1] = *(const f32x4*)(xr + 32 * j + 4); }
#pragma unroll
                for (int j = 0; j < 2; ++j)
#pragma unroll
                    for (int f = 0; f < 6; ++f) wq[j][f] = *(const bf16x8*)(rf + ((size_t)(j * 6 + f) * 64 + lane) * 8);
                __syncthreads();
#pragma unroll 1
                for (int kb4 = 0; kb4 < 32; kb4 += 4)
#pragma unroll
                for (int jq = 0; jq < 4; ++jq) { const int kb = kb4 + jq; const int c = 32 * kb + 8 * kg;
                    const f32x4 v0 = xq[jq][0], v1 = xq[jq][1];
                    bf16x8 wc6[6];
#pragma unroll
                    for (int f = 0; f < 6; ++f) wc6[f] = wq[jq & 1][f];
                    if (kb + 4 < 32) { xq[jq][0] = *(const f32x4*)(xr + 32 * (kb + 4)); xq[jq][1] = *(const f32x4*)(xr + 32 * (kb + 4) + 4); }
                    if (kb + 2 < 32) {
#pragma unroll
                        for (int f = 0; f < 6; ++f) wq[jq & 1][f] = *(const bf16x8*)(rf + ((size_t)((kb + 2) * 6 + f) * 64 + lane) * 8); }
                    const f32x4 a0 = *(const LAS f32x4*)(Av + c), a1 = *(const LAS f32x4*)(Av + c + 4), b0 = *(const LAS f32x4*)(Bv + c), b1 = *(const LAS f32x4*)(Bv + c + 4);
                    const f32x4 y0 = v0 * rstd * a0 + b0, y1 = v1 * rstd * a1 + b1;
                    const u32x4 hw = (u32x4){pk2(y0.x, y0.y), pk2(y0.z, y0.w), pk2(y1.x, y1.y), pk2(y1.z, y1.w)};
                    const u32x4 lw = (u32x4){pk2(y0.x - bflo(hw.x), y0.y - bfhi(hw.x)), pk2(y0.z - bflo(hw.y), y0.w - bfhi(hw.y)), pk2(y1.x - bflo(hw.z), y1.y - bfhi(hw.z)), pk2(y1.z - bflo(hw.w), y1.w - bfhi(hw.w))};
                    const bf16x8 Hh = __builtin_bit_cast(bf16x8, hw), Hl = __builtin_bit_cast(bf16x8, lw);
#pragma unroll
                    for (int cb = 0; cb < 3; ++cb) {
                        acc[cb] = __builtin_amdgcn_mfma_f32_16x16x32_bf16(wc6[2 * cb], Hh, acc[cb], 0, 0, 0);
                        acc[cb] = __builtin_amdgcn_mfma_f32_16x16x32_bf16(wc6[2 * cb], Hl, acc[cb], 0, 0, 0);
                        acc[cb] = __builtin_amdgcn_mfma_f32_16x16x32_bf16(wc6[2 * cb + 1], Hh, acc[cb], 0, 0, 0); }
                    *(u32x4*)(h2 + (size_t)tok * 1024 + c) = hw;
                }
#pragma unroll
                for (int cb = 0; cb < 3; ++cb)
#pragma unroll
                    for (int e = 0; e < 4; ++e) lg[r16 * 48 + 16 * cb + 4 * kg + e] = acc[cb][e] + rbias[l * 48 + 16 * cb + 4 * kg + e];
                __syncthreads();
                int e0 = 0, e1 = 0; float w0 = 0.f, w1 = 0.f;
                if (lane < 16) {
                    const LAS float* L = lg + lane * 48;
                    int gi = 0; float gm = L[32];
#pragma unroll
                    for (int g = 1; g < 4; ++g) { const float v = L[32 + g]; if (v > gm) { gm = v; gi = g; } }
                    float gs = 0.f;
#pragma unroll
                    for (int g = 0; g < 4; ++g) gs += expf(L[32 + g] - gm);
                    const float gwt = 1.0f / gs;
                    float v0 = -1e30f, v1 = -1e30f; int i0 = 0, i1 = 0;
#pragma unroll
                    for (int e = 0; e < 8; ++e) { const float v = L[gi * 8 + e]; if (v > v0) { v1 = v0; i1 = i0; v0 = v; i0 = e; } else if (v > v1) { v1 = v; i1 = e; } }
                    const float ex = expf(v1 - v0); w0 = gwt / (1.0f + ex); w1 = gwt * ex / (1.0f + ex);
                    e0 = gi * 8 + i0; e1 = gi * 8 + i1;
                    __hip_atomic_fetch_add(&hist[e0], 1, __ATOMIC_RELAXED, __HIP_MEMORY_SCOPE_WORKGROUP); __hip_atomic_fetch_add(&hist[e1], 1, __ATOMIC_RELAXED, __HIP_MEMORY_SCOPE_WORKGROUP);
                }
                __syncthreads();
                if (tid < 32) basel[tid] = dry ? 0 : (int)atomicAdd(gcnt + tid * 64, (unsigned)hist[tid]);
                __syncthreads();
                if (lane < 16 && !dry) {
                    const int p0 = basel[e0] + __hip_atomic_fetch_add(&hist2[e0], 1, __ATOMIC_RELAXED, __HIP_MEMORY_SCOPE_WORKGROUP), p1 = basel[e1] + __hip_atomic_fetch_add(&hist2[e1], 1, __ATOMIC_RELAXED, __HIP_MEMORY_SCOPE_WORKGROUP);
                    list[e0 * 32768 + p0] = tok; listw[e0 * 32768 + p0] = w0; list[e1 * 32768 + p1] = tok; listw[e1 * 32768 + p1] = w1;
                    tokslot[tok * 2] = e0 * 32768 + p0; tokslot[tok * 2 + 1] = e1 * 32768 + p1;
                }
                __syncthreads();
            }
        }
        SEAM(pb);
        if (IN(pb + 1) || IN(pb + 2) || IN(pb + 3)) {
            __syncthreads();
            if (tid == 0) { int accn = 0; for (int e = 0; e < 32; ++e) { const int c = (int)__hip_atomic_load(gcnt + e * 64, __ATOMIC_RELAXED, __HIP_MEMORY_SCOPE_AGENT); cntl[e] = c; tb[e] = accn; accn += (c + 255) >> 8; } tb[32] = accn; }
            __syncthreads();
        }
        if (IN(pb + 1)) {
            LAS int* tokl = (LAS int*)(lds + LDS_TOKL); LAS float* wl = (LAS float*)(lds + LDS_WL);
            volatile LAS int* ut = (volatile LAS int*)(lds + LDS_UT);
            if (tid == 0) pg8::build_units(ut, tb, 2, G, bx);
            __syncthreads();
            pg8::GroupedOrder S{ut, __builtin_amdgcn_readfirstlane(ut[32])};
            { pg8::Unit u; for (int ui = 0; ui < 4 && S.next(ui, u); ++ui) if (tid < 256) { const int pos = u.aux * 256 + tid; const bool ok = pos < cntl[u.eb];
                  tokl[ui * 256 + tid] = ok ? list[u.eb * 32768 + pos] : 0; wl[ui * 256 + tid] = ok ? listw[u.eb * 32768 + pos] : 0.f; } }
            __syncthreads();
            pg8::Gemm g{h2, MGU_T + (size_t)l * 32 * 512 * 1024, 1024, 1024, 1024, (size_t)512 * 1024};
            pg8::EpiAct E{actb, wl};
            pg8::gemm_phase<pg8::EpiAct, pg8::GroupedOrder, true>(lds, g, S, E, tokl);
        }
        SEAM(pb + 1);
        if (IN(pb + 2)) {
            volatile LAS int* ut = (volatile LAS int*)(lds + LDS_UT);
            if (tid == 0) pg8::build_units(ut, tb, 4, G, bx);
            __syncthreads();
            pg8::GroupedOrder S{ut, __builtin_amdgcn_readfirstlane(ut[32])};
            pg8::Gemm g{actb, MDN_T + (size_t)l * 32 * 1024 * 256, 256, 256, 256, (size_t)1024 * 256};
            pg8::EpiBf16<0> E{heb, 1024, nullptr, nullptr, 0};
            pg8::gemm_phase<pg8::EpiBf16<0>, pg8::GroupedOrder, false>(lds, g, S, E, nullptr);
        }
        SEAM(pb + 2);
        if (IN(pb + 3)) {
            for (int tok = gw; tok < T; tok += NGW) {
                const int s0 = tokslot[tok * 2], s1 = tokslot[tok * 2 + 1];
                const size_t r0 = (size_t)tb[s0 >> 15] * 256 + (s0 & 32767), r1 = (size_t)tb[s1 >> 15] * 256 + (s1 & 32767);
                const int b = tok >> 11; const float* g2 = modl + (size_t)b * 6144 + 5120;
                f32x4 y[4]; float ss = 0.f;
#pragma unroll
                for (int j = 0; j < 4; ++j) { const int c = 4 * lane + 256 * j; const f32x4 xv = *(const f32x4*)(xres + (size_t)tok * 1024 + c);
                    const u32x2 h0 = *(const u32x2*)(heb + r0 * 1024 + c), h1 = *(const u32x2*)(heb + r1 * 1024 + c);
                    const f32x4 m = (f32x4){bflo(h0.x) + bflo(h1.x), bfhi(h0.x) + bfhi(h1.x), bflo(h0.y) + bflo(h1.y), bfhi(h0.y) + bfhi(h1.y)};
                    y[j] = xv + *(const f32x4*)(g2 + c) * m; if (!dry) *(f32x4*)(xres + (size_t)tok * 1024 + c) = y[j];
                    ss += (y[j].x * y[j].x + y[j].y * y[j].y) + (y[j].z * y[j].z + y[j].w * y[j].w); }
                if (l == 0 && !dry) {
                    const float rstd = 1.0f / sqrtf(wave_sum(ss) * (1.0f / 1024.0f) + 1e-6f);
                    const float* m1 = mod + (size_t)(17 + b) * 6144;
#pragma unroll
                    for (int j = 0; j < 4; ++j) { const int c = 4 * lane + 256 * j;
                        const f32x4 o = y[j] * rstd * *(const f32x4*)(n1g + 1024 + c) * (*(const f32x4*)(m1 + 1024 + c) + 1.0f) + *(const f32x4*)(m1 + c);
                        u32x2 ow; ow.x = pk2(o.x, o.y); ow.y = pk2(o.z, o.w); *(u32x2*)(hb + (size_t)tok * 1024 + c) = ow; }
                }
            }
        }
        if (l == 0) SEAM(11);
}

__global__ void __launch_bounds__(512, 2) fwd(Args a) {
    using namespace cfg;
    extern __shared__ __attribute__((aligned(16))) unsigned char lds_raw[];
    LAS unsigned char* lds = (LAS unsigned char*)lds_raw;
    DECL_LOCALS
    volatile LAS unsigned* MISC = (volatile LAS unsigned*)(lds + LDS_MISC);
    if (tid < 16) MISC[tid] = 0u;
    __syncthreads();
    XcdBarrier bar; bar.bar = ctl + CW_BAR; bar.x = 0; bar.st = nullptr;
    const bool multi = (hi - lo) > 1;
    if (multi) bar = xcd_barrier_post(ctl + CW_BAR, MISC + 8);

    if (IN(0)) {
        if (bx < 192) {
            const int l = bx / 96, jb = bx % 96;
            LAS float* sl = (LAS float*)lds; LAS float* part = (LAS float*)(lds + 69632);
            for (int i = tid; i < 17 * 1024; i += 512) { const int r = i >> 10, k = i & 1023; const float v = (r < 16) ? cvec[r * 1024 + k] : cctx[k]; sl[i] = v / (1.0f + expf(-v)); }
            __syncthreads();
            float acc[17];
#pragma unroll
            for (int r = 0; r < 17; ++r) acc[r] = 0.f;
            const float* wp = w_ada + (size_t)l * 1024 * 6144 + jb * 64 + lane;
#pragma unroll 16
            for (int k = wid * 128; k < wid * 128 + 128; ++k) { const float w = wp[(size_t)k * 6144];
#pragma unroll
                for (int r = 0; r < 17; ++r) acc[r] += sl[r * 1024 + k] * w; }
#pragma unroll
            for (int r = 0; r < 17; ++r) part[(wid * 17 + r) * 64 + lane] = acc[r];
            __syncthreads();
            for (int i = tid; i < 17 * 64; i += 512) { const int r = i >> 6, j = i & 63; float s = 0.f;
#pragma unroll
                for (int q = 0; q < 8; ++q) s += part[(q * 17 + r) * 64 + j];
                mod[((size_t)l * 17 + r) * 6144 + jb * 64 + j] = s + b_ada[l * 6144 + jb * 64 + j]; }
            __syncthreads();
        }
        {
            LAS float* scr = (LAS float*)(lds + wid * 16384);
            constexpr int I_WIN = 16 * 53, I_UQ = 6 * 24, I_UKV = 4 * 32, I_OUT = 16 * 32, I_CIN = 16 * 128, I_COUT = 32 * 32, I_MOE = 64 * 384;
            constexpr int NITEMS = I_WIN + I_UQ + I_UKV + I_OUT + I_CIN + I_COUT + I_MOE;
            auto mk = [&](int it) -> TDesc {
                int r = it;
                if (r < I_WIN) return t_make(a_w_in, 1696, 64 * (r / 53), 32 * (r % 53), WIN_T, 1024, 32 * (r % 53), nullptr); r -= I_WIN;
                if (r < I_UQ) return t_make(a_w_uq, 768, 64 * (r / 24), 32 * (r % 24), WUQ_T, 384, 32 * (r % 24), a_qng); r -= I_UQ;
                if (r < I_UKV) return t_make(a_w_ukv, 1024, 64 * (r / 32), 32 * (r % 32), WUKV_T, 256, 32 * (r % 32), a_kvng); r -= I_UKV;
                if (r < I_OUT) return t_make(ab_w_out, 1024, 64 * (r / 32), 32 * (r % 32), WOUT_T, 1024, 32 * (r % 32), nullptr); r -= I_OUT;
                if (r < I_CIN) return t_make(c_w_in, 4096, 64 * (r / 128), 32 * (r % 128), CIN_T, 1024, 32 * (r % 128), nullptr); r -= I_CIN;
                if (r < I_COUT) return t_make(c_w_out, 1024, 64 * (r / 32), 32 * (r % 32), COUT_T, 2048, 32 * (r % 32), nullptr); r -= I_COUT;
                const int le = r / 384, q = r % 384;
                if (q < 128) { const int n0 = 32 * (q % 8); return t_make(m_gate + (size_t)le * 1024 * 256, 256, 64 * (q / 8), n0, MGU_T + (size_t)le * 512 * 1024, 1024, (n0 >> 7) * 256 + (n0 & 127), nullptr); }
                if (q < 256) { const int q2 = q - 128, n0 = 32 * (q2 % 8); return t_make(m_up + (size_t)le * 1024 * 256, 256, 64 * (q2 / 8), n0, MGU_T + (size_t)le * 512 * 1024, 1024, (n0 >> 7) * 256 + 128 + (n0 & 127), nullptr); }
                const int q2 = q - 256; return t_make(m_down + (size_t)le * 256 * 1024, 1024, 64 * (q2 / 32), 32 * (q2 % 32), MDN_T + (size_t)le * 1024 * 256, 256, 32 * (q2 % 32), nullptr);
            };
            const int nmod = (G > 192 ? 192 : G) * 8, wtot = nmod * 2 + (NGW - nmod) * 3;
            const int w0 = (gw < nmod) ? gw * 2 : nmod * 2 + (gw - nmod) * 3, w1 = w0 + ((gw < nmod) ? 2 : 3);
            const int it0 = (int)((long)w0 * NITEMS / wtot), it1 = (int)((long)w1 * NITEMS / wtot);
            if (it0 < it1) {
                TDesc dc = mk(it0); f32x4 vc[8]; t_load(dc, vc, lane);
                for (int it = it0; it < it1; ++it) {
                    const int itn = it + 1; TDesc dn = dc; f32x4 vn[8];
                    if (itn < it1) { dn = mk(itn); t_load(dn, vn, lane); }
                    t_finish(dc, vc, scr, lane);
                    if (itn < it1) { dc = dn;
#pragma unroll
                        for (int i = 0; i < 8; ++i) vc[i] = vn[i]; }
                }
            }
        }
        {
            const int gt = bx * 512 + tid, NGT = G * 512;
            for (int i = gt; i < 96 * 128; i += NGT) *(u32x4*)(WIN_T + (size_t)1696 * 1024 + (size_t)i * 8) = (u32x4){0u, 0u, 0u, 0u};
            for (int i = gt; i < 8 * 128 * 128 / 8; i += NGT) { const f32x4 v0 = *(const f32x4*)(c_w_s + (size_t)i * 8), v1 = *(const f32x4*)(c_w_s + (size_t)i * 8 + 4);
                *(u32x4*)(WSB + (size_t)i * 8) = (u32x4){pk2(v0.x, v0.y), pk2(v0.z, v0.w), pk2(v1.x, v1.y), pk2(v1.z, v1.w)}; }
            for (int i = gt; i < 2048 * 16; i += NGT) { const int pos = i >> 4, j = i & 15; const float p = (j < 8) ? (float)(pos >> 6) : (float)(pos & 63);
                const float ang = p * powf(10000.f, -(float)(j & 7) / 8.f); ropec[i] = cosf(ang); ropes[i] = sinf(ang); }
            for (int i = gt; i < 2 * 32 * 3 * 2 * 64; i += NGT) {
                const int ln = i & 63, hl = (i >> 6) & 1, rest = i >> 7, cb = rest % 3, kb = (rest / 3) % 32, l = rest / 96;
                const int o = 16 * cb + (ln & 15), d0 = 32 * kb + 8 * (ln >> 4); unsigned w[4];
#pragma unroll
                for (int jj = 0; jj < 4; ++jj) { float v[2];
#pragma unroll
                    for (int e = 0; e < 2; ++e) { const int d = d0 + 2 * jj + e; float f = 0.f;
                        if (o < 32) f = m_wr[(((size_t)l * 4 + (o >> 3)) * 1024 + d) * 8 + (o & 7)]; else if (o < 36) f = m_wg[((size_t)l * 1024 + d) * 4 + (o - 32)];
                        const float fh = __uint_as_float(pk2(f, 0.f) << 16); v[e] = hl ? (f - fh) : f; }
                    w[jj] = pk2(v[0], v[1]); }
                *(u32x4*)(rfrag + (size_t)i * 8) = (u32x4){w[0], w[1], w[2], w[3]}; }
            for (int i = gt; i < 2 * 48; i += NGT) { const int l = i / 48, o = i % 48; rbias[i] = (o < 32) ? m_br[l * 32 + o] : (o < 36 ? m_bg[l * 4 + o - 32] : 0.f); }
        }
    }
    SEAM(0);
    if (IN(1)) {
        for (int row = gw; row < TA; row += NGW) {
            const float* src; const float* md;
            if (row < T) { src = x + (size_t)row * 1024; md = mod + (size_t)(row >> 11) * 6144; } else { src = ctx + (size_t)(row - T) * 1024; md = mod + (size_t)16 * 6144; }
            norm_mod_row(src, n1g, md, md + 1024, hb + (size_t)row * 1024, lane);
        }
    }
    SEAM(1);
    if (IN(2)) {
        pg8::Gemm g{hb, WIN_T, 1024, 1024, 1024, 0}; pg8::StaticOrder S; S.init(TA, AINP, G, bx);
        pg8::EpiBf16<0> E{proj, AINP, nullptr, nullptr, 0};
        pg8::gemm_phase<pg8::EpiBf16<0>, pg8::StaticOrder, false>(lds, g, S, E, nullptr);
    }
    SEAM(2);
    if (IN(3)) {
        for (int row = gw; row < TA; row += NGW) {
            const bf16_t* pr = proj + (size_t)row * AINP;
            { const u32x2 w = *(const u32x2*)(pr + 384 + 4 * lane); const float v0 = bflo(w.x), v1 = bfhi(w.x), v2 = bflo(w.y), v3 = bfhi(w.y);
              const float rstd = 1.0f / sqrtf(wave_sum((v0 * v0 + v1 * v1) + (v2 * v2 + v3 * v3)) * (1.0f / 256.0f) + 1e-6f);
              u32x2 o; o.x = pk2(v0 * rstd, v1 * rstd); o.y = pk2(v2 * rstd, v3 * rstd); *(u32x2*)(kvn + (size_t)row * 256 + 4 * lane) = o; }
            if (lane < 32) krb[(size_t)row * 32 + lane] = bf2f(pr[640 + lane]);
            if (row < T) {
                const unsigned* pq = (const unsigned*)(pr + 6 * lane); const unsigned w0 = pq[0], w1 = pq[1], w2 = pq[2];
                const float q0 = bflo(w0), q1 = bfhi(w0), q2 = bflo(w1), q3 = bfhi(w1), q4 = bflo(w2), q5 = bfhi(w2);
                const float rstd = 1.0f / sqrtf(wave_sum((q0 * q0 + q1 * q1) + (q2 * q2 + q3 * q3) + (q4 * q4 + q5 * q5)) * (1.0f / 384.0f) + 1e-6f);
                unsigned* oq = (unsigned*)(qn + (size_t)row * 384 + 6 * lane); oq[0] = pk2(q0 * rstd, q1 * rstd); oq[1] = pk2(q2 * rstd, q3 * rstd); oq[2] = pk2(q4 * rstd, q5 * rstd);
                const u32x4 av = *(const u32x4*)(pr + 672 + 8 * lane), bv = *(const u32x4*)(pr + 1184 + 8 * lane); u32x4 zo;
#pragma unroll
                for (int j = 0; j < 4; ++j) zo[j] = pk2(bflo(av[j]) * sigmoid_fast(bflo(bv[j])), bfhi(av[j]) * sigmoid_fast(bfhi(bv[j])));
                *(u32x4*)(zb + (size_t)row * 512 + 8 * lane) = zo;
            }
        }
    }
    SEAM(3);
    if (IN(4)) {
#ifndef DRY_SEL
#define DRY_SEL 0
#endif
        if (!(dry && DRY_SEL == 2)) {
        { pg8::Gemm g{qn, WUQ_T, 384, 384, 384, 0}; pg8::StaticOrder S; S.init(T, 768, G, bx); pg8::EpiBf16<0> E{qraw, 768, nullptr, nullptr, 0};
          pg8::gemm_phase<pg8::EpiBf16<0>, pg8::StaticOrder, false>(lds, g, S, E, nullptr); }
        { pg8::Gemm g{kvn, WUKV_T, 256, 256, 256, 0}; pg8::StaticOrder S; S.init(TA, 1024, G, bx); pg8::EpiBf16<0> E{kvraw, 1024, nullptr, nullptr, 0};
          pg8::gemm_phase<pg8::EpiBf16<0>, pg8::StaticOrder, false>(lds, g, S, E, nullptr); }
        }
        __syncthreads();
        if (!(dry && DRY_SEL == 1)) {
        LAS unsigned char* zin = lds; LAS float* cvo = (LAS float*)(lds + 63488);
        float wd[31];
#pragma unroll
        for (int w = 0; w < 31; ++w) wd[w] = b_w_dw[w * 512 + tid];
        const float cbias = b_b_dw[tid];
        for (int u = bx; u < 1024; u += G) {
            const int b = u >> 6, t0 = (u & 63) * 32;
            { u32x4 tv[8];
#pragma unroll
              for (int j = 0; j < 8; ++j) { const int idx = tid + 512 * j, i = idx >> 6, c16 = idx & 63, tt = t0 - 15 + i;
                  tv[j] = (u32x4){0u, 0u, 0u, 0u}; if (idx < 62 * 64 && tt >= 0 && tt < 2048) tv[j] = *(const u32x4*)(zb + ((size_t)(b * 2048 + tt)) * 512 + c16 * 8); }
#pragma unroll
              for (int j = 0; j < 8; ++j) { const int idx = tid + 512 * j; if (idx < 62 * 64) *(LAS u32x4*)(zin + (idx >> 6) * 1024 + (idx & 63) * 16) = tv[j]; } }
            __syncthreads();
            float zr[62];
#pragma unroll
            for (int i = 0; i < 62; ++i) zr[i] = bf2f(*(const LAS unsigned short*)(zin + i * 1024 + tid * 2));
#pragma unroll
            for (int t = 0; t < 32; ++t) { float av = cbias;
#pragma unroll
                for (int w = 0; w < 31; ++w) av += zr[t + w] * wd[w];
                cvo[t * 512 + tid] = av; }
            __syncthreads();
#pragma unroll
            for (int k = 0; k < 4; ++k) { const int t = wid * 4 + k; const f32x4 v0 = *(const LAS f32x4*)(cvo + t * 512 + 8 * lane), v1 = *(const LAS f32x4*)(cvo + t * 512 + 8 * lane + 4);
                const float mean = wave_sum((v0.x + v0.y) + (v0.z + v0.w) + (v1.x + v1.y) + (v1.z + v1.w)) * (1.0f / 512.0f);
                const f32x4 d0 = v0 - mean, d1 = v1 - mean;
                const float var = wave_sum((d0.x * d0.x + d0.y * d0.y) + (d0.z * d0.z + d0.w * d0.w) + (d1.x * d1.x + d1.y * d1.y) + (d1.z * d1.z + d1.w * d1.w)) * (1.0f / 512.0f);
                const float rstd = 1.0f / sqrtf(var + 1e-5f);
                const f32x4 g0 = *(const f32x4*)(b_ln_g + 8 * lane), g1 = *(const f32x4*)(b_ln_g + 8 * lane + 4), e0 = *(const f32x4*)(b_ln_b + 8 * lane), e1 = *(const f32x4*)(b_ln_b + 8 * lane + 4);
                const f32x4 y0 = d0 * rstd * g0 + e0, y1 = d1 * rstd * g1 + e1;
                u32x4 o; o.x = pk2(silu_fast(y0.x), silu_fast(y0.y)); o.y = pk2(silu_fast(y0.z), silu_fast(y0.w)); o.z = pk2(silu_fast(y1.x), silu_fast(y1.y)); o.w = pk2(silu_fast(y1.z), silu_fast(y1.w));
                *(u32x4*)(concat + ((size_t)(b * 2048 + t0 + t)) * 1024 + 512 + 8 * lane) = o; }
            __syncthreads();
        }
        }
    }
    SEAM(4);
    if (IN(5)) {
        const int h = lane >> 3, l8 = lane & 7;
        const f32x4 kg0 = *(const f32x4*)(a_kg + 8 * l8), kg1 = *(const f32x4*)(a_kg + 8 * l8 + 4), qg0 = *(const f32x4*)(a_qg + 8 * l8), qg1 = *(const f32x4*)(a_qg + 8 * l8 + 4);
        const f32x2 kgr1 = *(const f32x2*)(a_kg + 64 + 2 * l8), kgr2 = *(const f32x2*)(a_kg + 80 + 2 * l8), qgr1 = *(const f32x2*)(a_qg + 64 + 2 * l8), qgr2 = *(const f32x2*)(a_qg + 80 + 2 * l8);
        for (int row = gw; row < TA; row += NGW) {
            int b, key, pos; bool rope;
            if (row < T) { b = row >> 11; pos = row & 2047; key = 256 + pos; rope = true; } else { const int rc = row - T; b = rc >> 8; key = rc & 255; pos = 0; rope = false; }
            const int bh = b * 8 + h;
            f32x2 cs = (f32x2){1.f, 1.f}, sn = (f32x2){0.f, 0.f};
            if (rope) { cs = *(const f32x2*)(ropec + pos * 16 + 2 * l8); sn = *(const f32x2*)(ropes + pos * 16 + 2 * l8); }
            {
                const u32x4 kw = *(const u32x4*)(kvraw + (size_t)row * 1024 + h * 128 + 8 * l8);
                const f32x2 x1 = *(const f32x2*)(krb + (size_t)row * 32 + 2 * l8), x2 = *(const f32x2*)(krb + (size_t)row * 32 + 16 + 2 * l8);
                float v[8];
#pragma unroll
                for (int j = 0; j < 4; ++j) { v[2 * j] = bflo(kw[j]); v[2 * j + 1] = bfhi(kw[j]); }
                float ss = (x1.x * x1.x + x1.y * x1.y) + (x2.x * x2.x + x2.y * x2.y);
#pragma unroll
                for (int j = 0; j < 8; ++j) ss += v[j] * v[j];
                ss += __shfl_xor(ss, 1); ss += __shfl_xor(ss, 2); ss += __shfl_xor(ss, 4);
                const float rstd = 1.0f / sqrtf(ss * (1.0f / 96.0f) + 1e-6f);
                bf16_t* ko = Kb + ((size_t)bh * NK + key) * 96;
                u32x4 o; o.x = pk2(v[0] * rstd * kg0.x, v[1] * rstd * kg0.y); o.y = pk2(v[2] * rstd * kg0.z, v[3] * rstd * kg0.w); o.z = pk2(v[4] * rstd * kg1.x, v[5] * rstd * kg1.y); o.w = pk2(v[6] * rstd * kg1.z, v[7] * rstd * kg1.w);
                *(u32x4*)(ko + 8 * l8) = o;
                const f32x2 a1 = x1 * rstd * kgr1, a2 = x2 * rstd * kgr2;
                const f32x2 o1 = a1 * cs - a2 * sn, o2 = a1 * sn + a2 * cs;
                *(unsigned*)(ko + 64 + 2 * l8) = pk2(o1.x, o1.y); *(unsigned*)(ko + 80 + 2 * l8) = pk2(o2.x, o2.y);
                *(u32x4*)(Vb + ((size_t)bh * NK + key) * 64 + 8 * l8) = *(const u32x4*)(kvraw + (size_t)row * 1024 + h * 128 + 64 + 8 * l8);
            }
            if (row < T) {
                const bf16_t* qp = qraw + (size_t)row * 768 + h * 96;
                const u32x4 qw = *(const u32x4*)(qp + 8 * l8); const unsigned r1 = *(const unsigned*)(qp + 64 + 2 * l8), r2 = *(const unsigned*)(qp + 80 + 2 * l8);
                float v[8];
#pragma unroll
                for (int j = 0; j < 4; ++j) { v[2 * j] = bflo(qw[j]); v[2 * j + 1] = bfhi(qw[j]); }
                const f32x2 x1 = (f32x2){bflo(r1), bfhi(r1)}, x2 = (f32x2){bflo(r2), bfhi(r2)};
                float ss = (x1.x * x1.x + x1.y * x1.y) + (x2.x * x2.x + x2.y * x2.y);
#pragma unroll
                for (int j = 0; j < 8; ++j) ss += v[j] * v[j];
                ss += __shfl_xor(ss, 1); ss += __shfl_xor(ss, 2); ss += __shfl_xor(ss, 4);
                const float rstd = QSCALE / sqrtf(ss * (1.0f / 96.0f) + 1e-6f);
                bf16_t* qo = Qb + ((size_t)bh * 2048 + pos) * 96;
                u32x4 o; o.x = pk2(v[0] * rstd * qg0.x, v[1] * rstd * qg0.y); o.y = pk2(v[2] * rstd * qg0.z, v[3] * rstd * qg0.w); o.z = pk2(v[4] * rstd * qg1.x, v[5] * rstd * qg1.y); o.w = pk2(v[6] * rstd * qg1.z, v[7] * rstd * qg1.w);
                *(u32x4*)(qo + 8 * l8) = o;
                const f32x2 a1 = x1 * rstd * qgr1, a2 = x2 * rstd * qgr2;
                const f32x2 o1 = a1 * cs - a2 * sn, o2 = a1 * sn + a2 * cs;
                *(unsigned*)(qo + 64 + 2 * l8) = pk2(o1.x, o1.y); *(unsigned*)(qo + 80 + 2 * l8) = pk2(o2.x, o2.y);
            }
        }
    }
    SEAM(5);
    if (IN(6)) {
        const int vcu = (G % 8 == 0) ? (bx % 8) * (G / 8) + bx / 8 : bx;
        for (int U = vcu; U < 1024; U += G) att::attn_unit(U >> 3, U & 7, Qb, Kb, Vb, concat, lds);
        asm volatile("s_waitcnt vmcnt(0) lgkmcnt(0)\n\ts_barrier" ::: "memory");
    }
    SEAM(6);
    if (IN(7)) {
        pg8::Gemm g{concat, WOUT_T, 1024, 1024, 1024, 0}; pg8::StaticOrder S; S.init(T, 1024, G, bx);
        pg8::EpiResid E{x, xres, mod + 2048, 6144, dry, ssq};
        pg8::gemm_phase<pg8::EpiResid, pg8::StaticOrder, false>(lds, g, S, E, nullptr);
    }
    SEAM(7);

    layer_tail<0>(a, lds, bar);
    layer_tail<1>(a, lds, bar);
}
#undef IN
#undef SEAM

extern "C" void kernel_launch(void* const* d_in, const int* in_sizes, int n_in, void* d_out, int out_size, void* d_ws, size_t ws_size, hipStream_t stream) {
    using namespace cfg;
    static int grid = 0;
    if (grid == 0) {
        if (n_in != 34 || out_size != T * D || ws_size < WS_NEED) { fprintf(stderr, "kernel_launch: unexpected problem shape or workspace (%d inputs, out %d, ws %zu)\n", n_in, out_size, ws_size); grid = -1; return; }
        int dev = 0, cus = 0, per_cu = 0;
        if (hipGetDevice(&dev) != hipSuccess || hipDeviceGetAttribute(&cus, hipDeviceAttributeMultiprocessorCount, dev) != hipSuccess) { grid = -1; return; }
        if (hipFuncSetAttribute((const void*)fwd, hipFuncAttributeMaxDynamicSharedMemorySize, LDS_BYTES) != hipSuccess) { fprintf(stderr, "kernel_launch: hipFuncSetAttribute failed\n"); grid = -1; return; }
        if (hipOccupancyMaxActiveBlocksPerMultiprocessor(&per_cu, (const void*)fwd, 512, LDS_BYTES) != hipSuccess || per_cu < 1) { fprintf(stderr, "kernel_launch: occupancy query reports %d\n", per_cu); }
        (void)hipGetLastError();
        grid = cus;
    }
    if (grid < 0) return;
    (void)hipMemsetAsync((char*)d_ws + OFF_CTL, 0, CTL_BYTES, stream);
    Args a{};
    for (int i = 0; i < 34; ++i) a.in[i] = (const float*)d_in[i];
    a.out = (float*)d_out; a.ws = (unsigned char*)d_ws;
#ifndef MK_ONE_LAUNCH
#define MK_ONE_LAUNCH 0
#endif
    if (MK_ONE_LAUNCH) { a.ph_lo = 0; a.ph_hi = NPHASE; hipLaunchKernelGGL(fwd, dim3(grid), dim3(512), LDS_BYTES, stream, a); }
#ifndef DUP_MASK
#define DUP_MASK 0
#endif
#ifndef DUP_N
#define DUP_N 1
#endif
    else for (int p = 0; p < NPHASE; ++p) { const int reps = 1 + (((DUP_MASK) >> p) & 1) * (DUP_N);
        for (int r = 0; r < reps; ++r) { a.ph_lo = p; a.ph_hi = p + 1; a.dry = (r > 0) ? 1 : 0; hipLaunchKernelGGL(fwd, dim3(grid), dim3(512), LDS_BYTES, stream, a); } }
}
```
